# Optimizing an MI355X kernel written in HIP

```python
import math
import jax, jax.numpy as jnp
from jax import lax
import numpy as np

D_MODEL = 2048
BATCH = 2
SEQ = 4096
DEPTH = 1

CHUNK = 64
SB_HEADS = 8
SB_HEAD_DIM = 128
SB_WIDTH = SB_HEADS * SB_HEAD_DIM
SB_QBLOCK = 128
HG_HEADS = 8
HG_KEY_DIM = 128
HG_VAL_DIM = 128
HG_WIDTH = HG_HEADS * HG_KEY_DIM
HG_VWIDTH = HG_HEADS * HG_VAL_DIM
RMS_EPS = 1e-6
PEER_HEADS = 8
PEER_HALF = 128
PEER_QDIM = 2 * PEER_HALF
N_KEYS = 128
N_EXPERTS = N_KEYS * N_KEYS
PEER_TOPK = 16
PEER_TOKBLOCK = 128
DEEPNORM_ALPHA = (2.0 * DEPTH) ** 0.25
DEEPNORM_BETA = (8.0 * DEPTH) ** -0.25
LN_EPS = 1e-5
IN_SIZES = (SB_WIDTH, SB_WIDTH, SB_WIDTH,
            HG_WIDTH, HG_WIDTH, HG_VWIDTH, HG_VWIDTH,
            D_MODEL, D_MODEL)
IN_OFFSETS = tuple(int(v) for v in np.cumsum(IN_SIZES)[:-1])
D_IN = int(sum(IN_SIZES))

kernel_name = "hybrid_sb_hgrn2_peer_deepnorm_block"


def layer_norm(x, g, b):
    xf = x.astype(jnp.float32)
    mu = jnp.mean(xf, axis=-1, keepdims=True)
    var = jnp.mean(jnp.square(xf - mu), axis=-1, keepdims=True)
    y = (xf - mu) * lax.rsqrt(var + LN_EPS) * g.astype(jnp.float32) + b.astype(jnp.float32)
    return y.astype(x.dtype)


def split_heads(t, n_heads):
    bsz, seq, _ = t.shape
    return t.reshape(bsz, seq, n_heads, -1).transpose(0, 2, 1, 3)


def merge_heads(t):
    bsz, nh, seq, d = t.shape
    return t.transpose(0, 2, 1, 3).reshape(bsz, seq, nh * d)


def stick_breaking_attention(q, k, v):
    seq = q.shape[2]
    scale = 1.0 / math.sqrt(q.shape[-1])
    outs = []
    for blk in range(seq // SB_QBLOCK):
        start = blk * SB_QBLOCK
        end = start + SB_QBLOCK
        z = jnp.einsum('bhqd,bhkd->bhqk', q[:, :, start:end], k[:, :, :end]) * scale
        t_pos = start + jnp.arange(SB_QBLOCK)
        s_pos = jnp.arange(end)
        mask = s_pos[None, :] < t_pos[:, None]
        log_1mb = jnp.where(mask, jax.nn.log_sigmoid(-z), 0.0)
        tail = lax.cumsum(log_1mb, axis=3, reverse=True) - log_1mb
        w = jnp.where(mask, jnp.exp(jax.nn.log_sigmoid(z) + tail), 0.0)
        outs.append(jnp.einsum('bhqk,bhkd->bhqd', w, v[:, :, :end]))
    return jnp.concatenate(outs, axis=2)


def hgrn2_chunk_scan(q, k, log_f, v):
    bsz, nh, seq, dk = q.shape
    dv = v.shape[-1]
    nc = seq // CHUNK

    def to_chunks(t):
        return t.reshape(bsz, nh, nc, CHUNK, t.shape[-1]).transpose(2, 0, 1, 3, 4)

    causal = jnp.tril(jnp.ones((CHUNK, CHUNK), dtype=bool))

    def step(state, inp):
        qc, kc, lfc, vc = inp
        b = jnp.cumsum(lfc, axis=2)
        diff = b[:, :, :, None, :] - b[:, :, None, :, :]
        decay = jnp.exp(jnp.where(causal[:, :, None], diff, -jnp.inf))
        scores = jnp.einsum('bhtd,bhsd,bhtsd->bhts', qc, kc, decay)
        o = (jnp.einsum('bhts,bhse->bhte', scores, vc)
             + jnp.einsum('bhtd,bhde->bhte', qc * jnp.exp(b), state))
        b_last = b[:, :, -1:, :]
        new_state = (jnp.exp(b_last[:, :, 0, :])[..., None] * state
                     + jnp.einsum('bhsd,bhse->bhde', kc * jnp.exp(b_last - b), vc))
        return new_state, o

    init = jnp.zeros((bsz, nh, dk, dv), jnp.float32)
    _, o = lax.scan(step, init, (to_chunks(q), to_chunks(k), to_chunks(log_f), to_chunks(v)))
    return o.transpose(1, 2, 0, 3, 4).reshape(bsz, nh, seq, dv)


def hybrid_mixer(h, w_in, lower_bound, hg_norm_g, w_branch_a, w_branch_b, w_out):
    f32 = jnp.float32
    proj = h @ w_in
    sb_q, sb_k, sb_v, hg_q, hg_f, hg_i, hg_g, gate_a, gate_b = jnp.split(proj, IN_OFFSETS, axis=-1)
    a_out = stick_breaking_attention(split_heads(sb_q, SB_HEADS).astype(f32),
                                     split_heads(sb_k, SB_HEADS).astype(f32),
                                     split_heads(sb_v, SB_HEADS).astype(f32))
    a_out = merge_heads(a_out).astype(h.dtype)
    lb = lower_bound.astype(f32).reshape(HG_HEADS, 1, HG_KEY_DIM)
    fgate = lb + (1.0 - lb) * jax.nn.sigmoid(split_heads(hg_f, HG_HEADS).astype(f32))
    o = hgrn2_chunk_scan(split_heads(hg_q, HG_HEADS).astype(f32), 1.0 - fgate, jnp.log(fgate),
                         split_heads(hg_i, HG_HEADS).astype(f32))
    o = o * lax.rsqrt(jnp.mean(jnp.square(o), axis=-1, keepdims=True) + RMS_EPS)
    b_out = (merge_heads(o) * hg_norm_g.astype(f32)
             * jax.nn.silu(hg_g.astype(f32))).astype(h.dtype)
    merged = jax.nn.sigmoid(gate_a) * (a_out @ w_branch_a) + jax.nn.sigmoid(gate_b) * (b_out @ w_branch_b)
    return merged @ w_out


def peer_ffn(h, w_q, sub_keys, u_tab, v_tab):
    bsz, seq, d = h.shape
    n_tok = bsz * seq
    hf = h.reshape(n_tok, d)
    q = (hf @ w_q).reshape(n_tok, PEER_HEADS, 2, PEER_HALF).astype(jnp.float32)
    half_scores = jnp.einsum('thpd,hpnd->thpn', q, sub_keys.astype(jnp.float32))
    s_top, i_top = lax.top_k(half_scores, PEER_TOPK)
    cand = (s_top[:, :, 0, :, None] + s_top[:, :, 1, None, :]).reshape(n_tok, PEER_HEADS, -1)
    cand_idx = (i_top[:, :, 0, :, None] * N_KEYS + i_top[:, :, 1, None, :]).reshape(n_tok, PEER_HEADS, -1)
    best, pos = lax.top_k(cand, PEER_TOPK)
    expert_idx = jnp.take_along_axis(cand_idx, pos, axis=-1)
    gates = jax.nn.softmax(best, axis=-1).astype(h.dtype)
    n_blk = n_tok // PEER_TOKBLOCK

    def block(args):
        xb, ib, gb = args
        act = jnp.einsum('td,thkd->thk', xb, u_tab[ib])
        w = gb * jax.nn.gelu(act, approximate=False)
        return jnp.einsum('thk,thkd->td', w, v_tab[ib])

    out = lax.map(block, (hf.reshape(n_blk, PEER_TOKBLOCK, d),
                          expert_idx.reshape(n_blk, PEER_TOKBLOCK, PEER_HEADS, PEER_TOPK),
                          gates.reshape(n_blk, PEER_TOKBLOCK, PEER_HEADS, PEER_TOPK)))
    return out.reshape(bsz, seq, d)


def setup_inputs(seed: int = 0) -> dict:
    key = jax.random.key(seed)
    ks = jax.random.split(key, 20)

    def nrm(k, shape, scale):
        return jax.random.normal(k, shape, jnp.float32) * scale

    L = DEPTH
    return {
        "x": nrm(ks[0], (BATCH, SEQ, D_MODEL), 1.0),
        "c": nrm(ks[1], (BATCH, D_MODEL), 1.0),
        "w_ada": nrm(ks[2], (L, D_MODEL, 6 * D_MODEL), 0.5 * D_MODEL ** -0.5),
        "b_ada": nrm(ks[3], (L, 6 * D_MODEL), 0.01),
        "w_in": nrm(ks[4], (L, D_MODEL, D_IN), D_MODEL ** -0.5),
        "hg_lb_logits": nrm(ks[5], (DEPTH + 1, HG_WIDTH), 0.1),
        "hg_norm_g": 1.0 + nrm(ks[6], (L, HG_VWIDTH), 0.02),
        "w_branch_a": nrm(ks[7], (L, SB_WIDTH, D_MODEL), SB_WIDTH ** -0.5),
        "w_branch_b": nrm(ks[8], (L, HG_VWIDTH, D_MODEL), HG_VWIDTH ** -0.5),
        "w_out": nrm(ks[9], (L, D_MODEL, D_MODEL), DEEPNORM_BETA * D_MODEL ** -0.5),
        "ln1_g": 1.0 + nrm(ks[10], (L, D_MODEL), 0.02),
        "ln1_b": nrm(ks[11], (L, D_MODEL), 0.02),
        "peer_wq": nrm(ks[12], (L, D_MODEL, PEER_HEADS * PEER_QDIM), D_MODEL ** -0.5),
        "peer_subkeys": nrm(ks[13], (L, PEER_HEADS, 2, N_KEYS, PEER_HALF), PEER_HALF ** -0.5),
        "peer_u": nrm(ks[14], (L, N_EXPERTS, D_MODEL), D_MODEL ** -0.5),
        "peer_v": nrm(ks[15], (L, N_EXPERTS, D_MODEL), DEEPNORM_BETA),
        "ln2_g": 1.0 + nrm(ks[16], (L, D_MODEL), 0.02),
        "ln2_b": nrm(ks[17], (L, D_MODEL), 0.02),
    }


def reference(x, c, w_ada, b_ada, w_in, hg_lb_logits, hg_norm_g, w_branch_a, w_branch_b, w_out,
              ln1_g, ln1_b, peer_wq, peer_subkeys, peer_u, peer_v, ln2_g, ln2_b):
    lower_bounds = jnp.cumsum(jax.nn.softmax(hg_lb_logits.astype(jnp.float32), axis=0), axis=0)
    cond = jax.nn.silu(c)
    for layer in range(DEPTH):
        mod = cond @ w_ada[layer] + b_ada[layer]
        shift1, scale1, gate1, shift2, scale2, gate2 = [m[:, None, :] for m in jnp.split(mod, 6, axis=-1)]
        h = x * (1.0 + scale1) + shift1
        y = hybrid_mixer(h, w_in[layer], lower_bounds[layer], hg_norm_g[layer],
                         w_branch_a[layer], w_branch_b[layer], w_out[layer])
        x = layer_norm(DEEPNORM_ALPHA * x + (1.0 + gate1) * y, ln1_g[layer], ln1_b[layer])
        h = x * (1.0 + scale2) + shift2
        y = peer_ffn(h, peer_wq[layer], peer_subkeys[layer], peer_u[layer], peer_v[layer])
        x = layer_norm(DEEPNORM_ALPHA * x + (1.0 + gate2) * y, ln2_g[layer], ln2_b[layer])
    return x
```

```cpp
#include <hip/hip_runtime.h>
#include <cstdio>
#include <cstdint>

#define LAS __attribute__((address_space(3)))
typedef unsigned short bf16_t;
typedef short bf16x8 __attribute__((ext_vector_type(8)));
typedef float f32x4 __attribute__((ext_vector_type(4)));
typedef float f32x2 __attribute__((ext_vector_type(2)));
typedef float f32x16 __attribute__((ext_vector_type(16)));
typedef unsigned u32x4 __attribute__((ext_vector_type(4)));
typedef int i32x4 __attribute__((ext_vector_type(4)));
typedef unsigned u32x2 __attribute__((ext_vector_type(2)));

constexpr int NB = 2, SEQ = 4096, DM = 2048, NT = NB * SEQ, DIN = 11264;
constexpr int NH = 8, HD = 128, HW = 1024;
constexpr int NEXP = 16384, NKEYS = 128, TOPK = 16, PH = 8;
constexpr float ALPHA = 1.189207115002721f;
constexpr float LN_EPS = 1e-5f, RMS_EPS = 1e-6f;
constexpr float LOG2E = 1.4426950408889634f;
constexpr int NTHR = 512;

constexpr size_t MB = 1024 * 1024;
constexpr size_t WS_BAR   = 0;
constexpr size_t WS_MOD   = 64 * 1024;
constexpr size_t WS_LB    = WS_MOD + 128 * 1024;
constexpr size_t WS_STAT1 = WS_LB + 4096;
constexpr size_t WS_HGAM  = WS_STAT1 + 65536;
constexpr size_t WS_RIDX  = 1 * MB;
constexpr size_t WS_RGATE = WS_RIDX + 4 * MB;
constexpr size_t WS_HST   = WS_RGATE + 4 * MB;
constexpr size_t WS_WINT  = WS_HST + 16 * MB;
constexpr size_t WS_WAT   = WS_WINT + 44 * MB;
constexpr size_t WS_WBT   = WS_WAT + 4 * MB;
constexpr size_t WS_WOT   = WS_WBT + 4 * MB;
constexpr size_t WS_WQT   = WS_WOT + 8 * MB;
constexpr size_t WS_SKB   = WS_WQT + 8 * MB;
constexpr size_t WS_UQ    = WS_SKB + 1 * MB;
constexpr size_t WS_VQ    = WS_UQ + 32 * MB;
constexpr size_t WS_USC   = WS_VQ + 32 * MB;
constexpr size_t WS_VSC   = WS_USC + 64 * 1024;
constexpr size_t WS_SH    = WS_USC + 128 * 1024;
constexpr size_t WS_SW    = WS_SH + 64 * 1024;
constexpr size_t WS_SH2   = WS_SH + 32 * 1024;
constexpr size_t WS_SWQ   = WS_SH + 112 * 1024;
constexpr size_t WS_RUS   = WS_USC + 1 * MB;
constexpr size_t WS_WQ8   = WS_USC + 8 * MB;
constexpr size_t WS_WQ8B  = WS_WQ8 + 24 * MB;
constexpr size_t WS_VBF   = WS_UQ + 64 * MB;
constexpr size_t WS_HBF   = WS_VBF + 64 * MB;
constexpr size_t WS_AB    = WS_HBF;
constexpr size_t WS_PROJ  = WS_HBF + 32 * MB;
constexpr size_t WS_Q     = WS_PROJ;
constexpr size_t WS_K     = WS_Q + 16 * MB;
constexpr size_t WS_VT    = WS_K + 16 * MB;
constexpr size_t WS_HQ    = WS_VT + 16 * MB;
constexpr size_t WS_HF    = WS_HQ + 16 * MB;
constexpr size_t WS_HI    = WS_HF + 16 * MB;
constexpr size_t WS_HG    = WS_HI + 16 * MB;
constexpr size_t WS_GA    = WS_HG + 16 * MB;
constexpr size_t WS_GB    = WS_GA + 32 * MB;
constexpr size_t WS_END   = WS_GB + 32 * MB;
constexpr size_t WS_MERGED = WS_Q;
constexpr size_t WS_R1     = WS_VT;
constexpr size_t WS_H2     = WS_GA;
constexpr size_t WS_QP     = WS_GB;

struct Params {
    const float *x, *c, *w_ada, *b_ada, *w_in, *lb_logits, *hg_norm_g, *w_a, *w_b, *w_out, *ln1_g, *ln1_b, *peer_wq, *subkeys, *peer_u, *peer_v, *ln2_g, *ln2_b;
    float* out;
    unsigned char* ws;
};

__device__ __forceinline__ int opaque_tid() { int t = threadIdx.x; asm volatile("" : "+v"(t)); return t; }
typedef __bf16 bf16x2_t __attribute__((ext_vector_type(2)));
__device__ __forceinline__ unsigned pk2(float lo, float hi) { const bf16x2_t v = __builtin_convertvector((f32x2){lo, hi}, bf16x2_t); return __builtin_bit_cast(unsigned, v); }
__device__ __forceinline__ float bf_lo(unsigned u) { return __uint_as_float(u << 16); }
__device__ __forceinline__ float bf_hi(unsigned u) { return __uint_as_float(u & 0xffff0000u); }
__device__ __forceinline__ float bf2f(bf16_t b) { return __uint_as_float(((unsigned)b) << 16); }
__device__ __forceinline__ bf16_t f2bf(float f) { return (bf16_t)(pk2(f, 0.f) & 0xffffu); }
__device__ __forceinline__ float fast_exp2(float x) { return __builtin_amdgcn_exp2f(x); }
__device__ __forceinline__ float fast_log2(float x) { return __builtin_amdgcn_logf(x); }
__device__ __forceinline__ float fast_rcp(float x) { return __builtin_amdgcn_rcpf(x); }
__device__ __forceinline__ float sigmoidf_(float v) { return fast_rcp(1.f + fast_exp2(-v * LOG2E)); }
__device__ __forceinline__ float siluf_(float v) { return v * sigmoidf_(v); }
__device__ __forceinline__ float wave_sum(float v) {
    v += __int_as_float(__builtin_amdgcn_update_dpp(0, __float_as_int(v), 0x111, 0xf, 0xf, false));
    v += __int_as_float(__builtin_amdgcn_update_dpp(0, __float_as_int(v), 0x112, 0xf, 0xf, false));
    v += __int_as_float(__builtin_amdgcn_update_dpp(0, __float_as_int(v), 0x114, 0xf, 0xf, false));
    v += __int_as_float(__builtin_amdgcn_update_dpp(0, __float_as_int(v), 0x118, 0xf, 0xf, false));
    const float t0 = __int_as_float(__builtin_amdgcn_readlane(__float_as_int(v), 15)), t1 = __int_as_float(__builtin_amdgcn_readlane(__float_as_int(v), 31)),
                t2 = __int_as_float(__builtin_amdgcn_readlane(__float_as_int(v), 47)), t3 = __int_as_float(__builtin_amdgcn_readlane(__float_as_int(v), 63));
    return (t0 + t1) + (t2 + t3);
}
__device__ __forceinline__ float wave_max_nonneg(float v) {
    v = fmaxf(v, __int_as_float(__builtin_amdgcn_update_dpp(0, __float_as_int(v), 0x111, 0xf, 0xf, false)));
    v = fmaxf(v, __int_as_float(__builtin_amdgcn_update_dpp(0, __float_as_int(v), 0x112, 0xf, 0xf, false)));
    v = fmaxf(v, __int_as_float(__builtin_amdgcn_update_dpp(0, __float_as_int(v), 0x114, 0xf, 0xf, false)));
    v = fmaxf(v, __int_as_float(__builtin_amdgcn_update_dpp(0, __float_as_int(v), 0x118, 0xf, 0xf, false)));
    const float t0 = __int_as_float(__builtin_amdgcn_readlane(__float_as_int(v), 15)), t1 = __int_as_float(__builtin_amdgcn_readlane(__float_as_int(v), 31)),
                t2 = __int_as_float(__builtin_amdgcn_readlane(__float_as_int(v), 47)), t3 = __int_as_float(__builtin_amdgcn_readlane(__float_as_int(v), 63));
    return fmaxf(fmaxf(t0, t1), fmaxf(t2, t3));
}

#define XB_TMO      128
#define XB_XCNT(j)  (256  + 64 * (j))
#define XB_XSUB(j)  (1280 + 64 * (j))
#define XB_XGEN(j)  (2304 + 64 * (j))
#define XB_TOP      3328
#define XB_TOPGEN   3392
#define XCD_BAR_WORDS 3456
#define XB_SPIN_CAP (1u << 22)
__device__ __forceinline__ unsigned xb_ld(unsigned* p)              { return __hip_atomic_load(p, __ATOMIC_RELAXED, __HIP_MEMORY_SCOPE_AGENT); }
__device__ __forceinline__ unsigned xb_add(unsigned* p, unsigned v) { return __hip_atomic_fetch_add(p, v, __ATOMIC_RELAXED, __HIP_MEMORY_SCOPE_AGENT); }
__device__ __forceinline__ unsigned xb_xcc_id() { return (unsigned)__builtin_amdgcn_s_getreg((3 << 11) | 20) & 0xFu; }
#define XB_SPIN(cond, bar) do { unsigned _sp = 0; while (cond) { __builtin_amdgcn_s_sleep(1); \
    if ((++_sp & 255u) == 0u) { if (xb_ld(&(bar)[XB_TMO])) break; if (_sp > XB_SPIN_CAP) { atomicAdd(&(bar)[XB_TMO], 1u); break; } } } } while (0)
struct XcdBarrier { unsigned* bar; unsigned x; volatile LAS unsigned* st; };
__device__ __forceinline__ XcdBarrier xcd_barrier_post(unsigned* bar, volatile LAS unsigned* st) {
    XcdBarrier b; b.bar = bar; b.x = xb_xcc_id(); b.st = st;
    if (threadIdx.x == 0) (void)xb_add(&bar[XB_XCNT(b.x)], 1u);
    return b;
}
__device__ __forceinline__ void xcd_barrier_complete(unsigned* bar, unsigned x, unsigned& nloc, unsigned& nx) {
    const unsigned G = gridDim.x * gridDim.y * gridDim.z;
    unsigned sum, cnt, mine, sp = 0u;
    for (;;) {
        sum = 0u; cnt = 0u; mine = 0u;
#pragma unroll
        for (unsigned j = 0; j < 16; ++j) { const unsigned c = xb_ld(&bar[XB_XCNT(j)]); sum += c; cnt += (c > 0u) ? 1u : 0u; mine = (j == x) ? c : mine; }
        if (sum == G) break;
        __builtin_amdgcn_s_sleep(1);
        if ((++sp & 255u) == 0u) { if (xb_ld(&bar[XB_TMO])) break; if (sp > XB_SPIN_CAP) { atomicAdd(&bar[XB_TMO], 1u); break; } }
    }
    nloc = mine > 0u ? mine : 1u; nx = cnt > 0u ? cnt : 1u;
}
__device__ __forceinline__ void xcd_barrier(const XcdBarrier& b) {
    asm volatile("s_waitcnt vmcnt(0)" ::: "memory");
    __syncthreads();
    if (threadIdx.x == 0) {
        unsigned* bar = b.bar;
        __builtin_amdgcn_s_waitcnt(0);
        unsigned nloc = b.st[0], nx = b.st[1];
        if (nloc == 0u) { xcd_barrier_complete(bar, b.x, nloc, nx); b.st[0] = nloc; b.st[1] = nx; }
        const unsigned old = xb_add(&bar[XB_XSUB(b.x)], 1u);
        const unsigned gen = old / nloc;
        if (old + 1u == (gen + 1u) * nloc) {
            __builtin_amdgcn_fence(__ATOMIC_RELEASE, "agent");
            asm volatile("s_waitcnt vmcnt(0)" ::: "memory");
            const unsigned og = xb_add(&bar[XB_TOP], 1u);
            const unsigned tg = og / nx;
            if (og + 1u == (tg + 1u) * nx) xb_add(&bar[XB_TOPGEN], 1u);
            else XB_SPIN(xb_ld(&bar[XB_TOPGEN]) == tg, bar);
            __builtin_amdgcn_fence(__ATOMIC_ACQUIRE, "agent");
            xb_add(&bar[XB_XGEN(b.x)], 1u);
            asm volatile("s_waitcnt vmcnt(0)" ::: "memory");
        } else {
            XB_SPIN((int)(xb_ld(&bar[XB_XGEN(b.x)]) - gen) <= 0, bar);
            __builtin_amdgcn_fence(__ATOMIC_ACQUIRE, "agent");
            asm volatile("s_waitcnt vmcnt(0)" ::: "memory");
        }
    }
    __syncthreads();
}

__device__ __forceinline__ void xcd_barrier_arrive(const XcdBarrier& b) {
    asm volatile("s_waitcnt vmcnt(0)" ::: "memory");
    __syncthreads();
    if (threadIdx.x == 0) {
        unsigned* bar = b.bar;
        __builtin_amdgcn_s_waitcnt(0);
        unsigned nloc = b.st[0], nx = b.st[1];
        if (nloc == 0u) { xcd_barrier_complete(bar, b.x, nloc, nx); b.st[0] = nloc; b.st[1] = nx; }
        const unsigned old = xb_add(&bar[XB_XSUB(b.x)], 1u);
        const unsigned gen = old / nloc;
        const unsigned leader = (old + 1u == (gen + 1u) * nloc) ? 1u : 0u;
        if (leader) {
            __builtin_amdgcn_fence(__ATOMIC_RELEASE, "agent");
            asm volatile("s_waitcnt vmcnt(0)" ::: "memory");
            const unsigned og = xb_add(&bar[XB_TOP], 1u);
            const unsigned tg = og / nx;
            if (og + 1u == (tg + 1u) * nx) xb_add(&bar[XB_TOPGEN], 1u);
        }
        b.st[2] = gen; b.st[3] = leader;
    }
}
__device__ __forceinline__ void xcd_barrier_wait(const XcdBarrier& b) {
    asm volatile("s_waitcnt vmcnt(0)" ::: "memory");
    __syncthreads();
    if (threadIdx.x == 0) {
        unsigned* bar = b.bar;
        const unsigned gen = b.st[2], leader = b.st[3];
        XB_SPIN((int)(xb_ld(&bar[XB_TOPGEN]) - gen) <= 0, bar);
        __builtin_amdgcn_fence(__ATOMIC_ACQUIRE, "agent");
        if (leader) xb_add(&bar[XB_XGEN(b.x)], 1u);
        asm volatile("s_waitcnt vmcnt(0)" ::: "memory");
    }
    __syncthreads();
}

__device__ __forceinline__ void phase_ada(const Params& p, LAS unsigned char* lds, int wg, int G) {
    LAS float* cond = (LAS float*)lds;
    LAS float* red = cond + 4096;
    const int tid = opaque_tid(), w = tid >> 6, lane = tid & 63;
    float* mod = (float*)(p.ws + WS_MOD);
    for (int i = tid; i < 2 * DM; i += NTHR) { const float v = p.c[i]; cond[i] = v / (1.f + __expf(-v)); }
    __syncthreads();
    const int r5 = lane / 12, c4 = lane % 12; const bool act = lane < 60;
    for (int item = wg; item < 256; item += G) {
        const int n0 = item * 48;
        f32x4 a0 = {0.f, 0.f, 0.f, 0.f}, a1 = {0.f, 0.f, 0.f, 0.f};
        if (act) {
#pragma unroll 4
            for (int k = w * 5 + r5; k < DM; k += 40) {
                const f32x4 wv = *(const f32x4*)(p.w_ada + (size_t)k * (6 * DM) + n0 + c4 * 4);
                const float c0 = cond[k], c1 = cond[DM + k];
                a0 += c0 * wv; a1 += c1 * wv;
            }
            LAS float* r = red + ((w * 5 + r5) * 12 + c4) * 8;
            *(LAS f32x4*)r = a0; *(LAS f32x4*)(r + 4) = a1;
        }
        __syncthreads();
        if (tid < 96) {
            const int b = tid / 48, n = tid % 48, cc = n >> 2, j = n & 3;
            float s = 0.f;
            for (int g = 0; g < 40; ++g) s += red[(g * 12 + cc) * 8 + b * 4 + j];
            mod[b * (6 * DM) + n0 + n] = s + p.b_ada[n0 + n];
        }
        __syncthreads();
    }
}

__device__ __forceinline__ void transpose_tile(const float* W, int K, int N, bf16_t* WT, int k0, int n0, LAS float* scr, int tid, int ldk = 0, int koff = 0) {
    if (ldk == 0) ldk = K;
#pragma unroll
    for (int i = 0; i < 2; ++i) {
        const int idx = tid + i * NTHR, r = idx >> 4, cq = idx & 15;
        const f32x4 v = *(const f32x4*)(W + (size_t)(k0 + r) * N + n0 + cq * 4);
        LAS float* d = scr + r * 65 + cq * 4;
        d[0] = v[0]; d[1] = v[1]; d[2] = v[2]; d[3] = v[3];
    }
    __syncthreads();
    {
        const int n = tid >> 3, kc = tid & 7;
        const LAS float* s = scr + (kc * 8) * 65 + n;
        u32x4 o; o.x = pk2(s[0], s[65]); o.y = pk2(s[2 * 65], s[3 * 65]); o.z = pk2(s[4 * 65], s[5 * 65]); o.w = pk2(s[6 * 65], s[7 * 65]);
        *(u32x4*)(WT + (size_t)(n0 + n) * ldk + koff + k0 + kc * 8) = o;
    }
    __syncthreads();
}
__device__ __forceinline__ void convert_chunk(const float* src, bf16_t* dst, size_t e0, int tid) {
    const f32x4 a = *(const f32x4*)(src + e0 + (size_t)tid * 8), b = *(const f32x4*)(src + e0 + (size_t)tid * 8 + 4);
    u32x4 o; o.x = pk2(a[0], a[1]); o.y = pk2(a[2], a[3]); o.z = pk2(b[0], b[1]); o.w = pk2(b[2], b[3]);
    *(u32x4*)(dst + e0 + (size_t)tid * 8) = o;
}
template <int OFFS>
__device__ __forceinline__ void quantize_row(const float* src, unsigned char* dst, float* scales, int row, int lane) {
    const float* s = src + (size_t)row * DM;
    f32x4 v[8]; float am = 0.f;
#pragma unroll
    for (int j = 0; j < 2; ++j)
#pragma unroll
        for (int q = 0; q < 4; ++q) { v[4 * j + q] = *(const f32x4*)(s + 1024 * j + 16 * lane + 4 * q);
            am = fmaxf(am, fmaxf(fmaxf(fabsf(v[4 * j + q][0]), fabsf(v[4 * j + q][1])), fmaxf(fabsf(v[4 * j + q][2]), fabsf(v[4 * j + q][3])))); }
    am = wave_max_nonneg(am);
    const float sc = am > 0.f ? am * (1.f / 127.f) : 1.f, inv = am > 0.f ? 127.f / am : 0.f;
    if (lane == 0) scales[row] = sc;
#pragma unroll
    for (int j = 0; j < 2; ++j) {
        unsigned wds[4];
#pragma unroll
        for (int q = 0; q < 4; ++q) {
            unsigned wd = 0;
#pragma unroll
            for (int k = 0; k < 4; ++k) { int qi = (int)rintf(v[4 * j + q][k] * inv); qi = qi < -127 ? -127 : (qi > 127 ? 127 : qi); wd |= ((unsigned)(qi + OFFS) & 0xffu) << (8 * k); }
            wds[q] = wd;
        }
        *(u32x4*)(dst + (size_t)row * DM + 1024 * j + 16 * lane) = (u32x4){wds[0], wds[1], wds[2], wds[3]};
    }
}
#ifndef V_FP6
#define V_FP6 1
#endif
#ifndef U_FP6
#define U_FP6 0
#endif
#ifndef V_FP4
#define V_FP4 1
#endif
constexpr int VROW = V_FP4 ? 1024 : (V_FP6 ? 1536 : 2048);
constexpr int UROW = U_FP6 ? 1536 : 2048;
typedef float f32x16v __attribute__((ext_vector_type(16)));
typedef float f32x32v __attribute__((ext_vector_type(32)));
typedef unsigned u32x6v __attribute__((ext_vector_type(6)));
typedef _Float16 f16x2v __attribute__((ext_vector_type(2)));
typedef _Float16 f16x8v __attribute__((ext_vector_type(8)));
typedef _Float16 f16x32v __attribute__((ext_vector_type(32)));
__device__ __forceinline__ u32x6v pack_fp6_2x16(const f32x16v& a, const f32x16v& b) {
    u32x6v r;
    asm volatile("v_cvt_scalef32_2xpk16_fp6_f32 %0, %1, %2, 1.0" : "=&v"(r) : "v"(a), "v"(b));
    return r;
}
__device__ __forceinline__ void utab_load(const Params& p, int row, int lane, f32x4 (&v)[8]) {
    const float* s = p.peer_u + (size_t)row * DM;
#pragma unroll
    for (int j = 0; j < 2; ++j)
#pragma unroll
        for (int q = 0; q < 4; ++q) v[4 * j + q] = *(const f32x4*)(s + 1024 * j + 16 * lane + 4 * q);
}
__device__ __forceinline__ void utab_quant_store(const Params& p, int row, int lane, const f32x4 (&v)[8]) {
    float am = 0.f;
#pragma unroll
    for (int i = 0; i < 8; ++i) am = fmaxf(am, fmaxf(fmaxf(fabsf(v[i][0]), fabsf(v[i][1])), fmaxf(fabsf(v[i][2]), fabsf(v[i][3]))));
    am = wave_max_nonneg(am);
#if U_FP6
    const float sc = am > 0.f ? am * (1.f / 7.5f) : 1.f, inv = am > 0.f ? 7.5f / am : 0.f;
    if (lane == 0) ((float*)(p.ws + WS_USC))[row] = sc;
    f32x16v a, b;
#pragma unroll
    for (int i = 0; i < 8; ++i) { a[2 * i] = v[i][0] * inv; b[2 * i] = v[i][1] * inv; a[2 * i + 1] = v[i][2] * inv; b[2 * i + 1] = v[i][3] * inv; }
    const u32x6v pk = pack_fp6_2x16(a, b);
    unsigned char* d = p.ws + WS_UQ + (size_t)row * UROW;
    *(u32x4*)(d + 16 * lane) = (u32x4){pk[0], pk[1], pk[2], pk[3]};
    *(u32x2*)(d + 1024 + 8 * lane) = (u32x2){pk[4], pk[5]};
#else
    const float sc = am > 0.f ? am * (1.f / 127.f) : 1.f, inv = am > 0.f ? 127.f / am : 0.f;
    if (lane == 0) ((float*)(p.ws + WS_USC))[row] = sc;
#pragma unroll
    for (int j = 0; j < 2; ++j) {
        unsigned wds[4];
#pragma unroll
        for (int q = 0; q < 4; ++q) { unsigned wd = 0;
#pragma unroll
            for (int k = 0; k < 4; ++k) { int qi = (int)rintf(v[4 * j + q][k] * inv); qi = qi < -127 ? -127 : (qi > 127 ? 127 : qi); wd |= ((unsigned)qi & 0xffu) << (8 * k); }
            wds[q] = wd; }
        *(u32x4*)(p.ws + WS_UQ + (size_t)row * DM + 1024 * j + 16 * lane) = (u32x4){wds[0], wds[1], wds[2], wds[3]};
    }
#endif
}
__device__ __forceinline__ void quantize_row_fp6(const float* src, unsigned char* dst, float* scales, int row, int lane) {
    const float* s = src + (size_t)row * DM;
    f32x4 v[8]; float am = 0.f;
#pragma unroll
    for (int j = 0; j < 2; ++j)
#pragma unroll
        for (int q = 0; q < 4; ++q) { v[4 * j + q] = *(const f32x4*)(s + 1024 * j + 16 * lane + 4 * q);
            am = fmaxf(am, fmaxf(fmaxf(fabsf(v[4 * j + q][0]), fabsf(v[4 * j + q][1])), fmaxf(fabsf(v[4 * j + q][2]), fabsf(v[4 * j + q][3])))); }
    am = wave_max_nonneg(am);
    const float sc = am > 0.f ? am * (1.f / 7.5f) : 1.f, inv = am > 0.f ? 7.5f / am : 0.f;
    if (lane == 0) scales[row] = sc;
    f32x16v a, b;
#pragma unroll
    for (int i = 0; i < 8; ++i) { a[2 * i] = v[i][0] * inv; b[2 * i] = v[i][1] * inv; a[2 * i + 1] = v[i][2] * inv; b[2 * i + 1] = v[i][3] * inv; }
    const u32x6v pk = pack_fp6_2x16(a, b);
    unsigned char* d = dst + (size_t)row * VROW;
    *(u32x4*)(d + 16 * lane) = (u32x4){pk[0], pk[1], pk[2], pk[3]};
    *(u32x2*)(d + 1024 + 8 * lane) = (u32x2){pk[4], pk[5]};
}
__device__ __forceinline__ void quantize_row_fp4(const float* src, unsigned char* dst, float* scales, int row, int lane) {
    const float* s = src + (size_t)row * DM;
    f32x4 v[8]; float am = 0.f;
#pragma unroll
    for (int j = 0; j < 2; ++j)
#pragma unroll
        for (int q = 0; q < 4; ++q) { v[4 * j + q] = *(const f32x4*)(s + 1024 * j + 16 * lane + 4 * q);
            am = fmaxf(am, fmaxf(fmaxf(fabsf(v[4 * j + q][0]), fabsf(v[4 * j + q][1])), fmaxf(fabsf(v[4 * j + q][2]), fabsf(v[4 * j + q][3])))); }
    am = wave_max_nonneg(am);
    const float sc = am > 0.f ? am * (1.f / 6.f) : 1.f, inv = am > 0.f ? 6.f / am : 0.f;
    if (lane == 0) scales[row] = sc;
    unsigned wd[4];
#pragma unroll
    for (int q = 0; q < 4; ++q) {
        unsigned w = 0;
        w = __builtin_amdgcn_cvt_scalef32_pk_fp4_f32(w, v[2 * q][0] * inv, v[2 * q][1] * inv, 1.0f, 0);
        w = __builtin_amdgcn_cvt_scalef32_pk_fp4_f32(w, v[2 * q][2] * inv, v[2 * q][3] * inv, 1.0f, 1);
        w = __builtin_amdgcn_cvt_scalef32_pk_fp4_f32(w, v[2 * q + 1][0] * inv, v[2 * q + 1][1] * inv, 1.0f, 2);
        w = __builtin_amdgcn_cvt_scalef32_pk_fp4_f32(w, v[2 * q + 1][2] * inv, v[2 * q + 1][3] * inv, 1.0f, 3);
        wd[q] = w;
    }
    *(u32x4*)(dst + (size_t)row * VROW + 16 * lane) = (u32x4){wd[0], wd[1], wd[2], wd[3]};
}
__device__ __forceinline__ void quantize_row_fp8(const float* src, unsigned char* dst, float* scales, int row, int lane) {
    const float* s = src + (size_t)row * DM;
    f32x4 v[8]; float am = 0.f;
#pragma unroll
    for (int j = 0; j < 2; ++j)
#pragma unroll
        for (int q = 0; q < 4; ++q) { v[4 * j + q] = *(const f32x4*)(s + 1024 * j + 16 * lane + 4 * q);
            am = fmaxf(am, fmaxf(fmaxf(fabsf(v[4 * j + q][0]), fabsf(v[4 * j + q][1])), fmaxf(fabsf(v[4 * j + q][2]), fabsf(v[4 * j + q][3])))); }
    am = wave_max_nonneg(am);
    const float sc = am > 0.f ? am * (1.f / 448.f) : 1.f, inv = am > 0.f ? 448.f / am : 0.f;
    if (lane == 0) scales[row] = sc;
#pragma unroll
    for (int j = 0; j < 2; ++j) {
        unsigned wds[4];
#pragma unroll
        for (int q = 0; q < 4; ++q) {
            int wd = __builtin_amdgcn_cvt_pk_fp8_f32(v[4 * j + q][0] * inv, v[4 * j + q][1] * inv, 0, false);
            wd = __builtin_amdgcn_cvt_pk_fp8_f32(v[4 * j + q][2] * inv, v[4 * j + q][3] * inv, wd, true);
            wds[q] = (unsigned)wd;
        }
        *(u32x4*)(dst + (size_t)row * DM + 1024 * j + 16 * lane) = (u32x4){wds[0], wds[1], wds[2], wds[3]};
    }
}
constexpr int TRS = 260;
__device__ __forceinline__ void tr_loop(const float* W, bf16_t* WT, int N, int ldk, int koff, int ntiles, int first, int G, LAS float* scr, int tid) {
    const int nb = N / 256;
    const int r0 = tid >> 6, cq = tid & 63;
    const int n = tid >> 1, kc = tid & 1;
    for (int r = first; r < ntiles; r += G) {
        const int k0 = (r / nb) * 64, n0 = (r % nb) * 256;
        f32x4 v[8];
#pragma unroll
        for (int i = 0; i < 8; ++i) v[i] = *(const f32x4*)(W + (size_t)(k0 + r0 + 8 * i) * N + n0 + cq * 4);
#pragma unroll
        for (int i = 0; i < 8; ++i) *(LAS f32x4*)(scr + (r0 + 8 * i) * TRS + cq * 4) = v[i];
        __syncthreads();
        const LAS float* s = scr + (kc * 32) * TRS + n;
        bf16_t* dst = WT + (size_t)(n0 + n) * ldk + koff + k0 + kc * 32;
#pragma unroll
        for (int q = 0; q < 4; ++q) {
            u32x4 o; o.x = pk2(s[(8 * q) * TRS], s[(8 * q + 1) * TRS]); o.y = pk2(s[(8 * q + 2) * TRS], s[(8 * q + 3) * TRS]);
            o.z = pk2(s[(8 * q + 4) * TRS], s[(8 * q + 5) * TRS]); o.w = pk2(s[(8 * q + 6) * TRS], s[(8 * q + 7) * TRS]);
            *(u32x4*)(dst + 8 * q) = o;
        }
        __syncthreads();
    }
}
__device__ __forceinline__ void colblock_quant(const float* W, int N, unsigned char* WQ, float* scales, int n0, LAS float* scr, int tid) {
    const int r0 = tid >> 4, cq = tid & 15;
    LAS float* red = scr + 64 * 65;
    f32x4 am = {0.f, 0.f, 0.f, 0.f};
#pragma unroll 8
    for (int i = 0; i < DM / 32; ++i) {
        const f32x4 v = *(const f32x4*)(W + (size_t)(r0 + 32 * i) * N + n0 + cq * 4);
        am[0] = fmaxf(am[0], fabsf(v[0])); am[1] = fmaxf(am[1], fabsf(v[1])); am[2] = fmaxf(am[2], fabsf(v[2])); am[3] = fmaxf(am[3], fabsf(v[3]));
    }
    *(LAS f32x4*)(red + r0 * 64 + cq * 4) = am;
    __syncthreads();
    if (tid < 64) { float m = 0.f; for (int g = 0; g < 32; ++g) m = fmaxf(m, red[g * 64 + tid]); scales[n0 + tid] = m > 0.f ? m * (1.f / 127.f) : 1.f; red[32 * 64 + tid] = m > 0.f ? 127.f / m : 0.f; }
    __syncthreads();
    const f32x4 inv = *(const LAS f32x4*)(red + 32 * 64 + cq * 4);
    const int n = tid >> 3, kc = tid & 7;
    f32x4 v[2];
#pragma unroll
    for (int i = 0; i < 2; ++i) v[i] = *(const f32x4*)(W + (size_t)(r0 + 32 * i) * N + n0 + cq * 4);
    for (int kt = 0; kt < DM / 64; ++kt) {
#pragma unroll
        for (int i = 0; i < 2; ++i) { LAS float* dd = scr + (r0 + 32 * i) * 65 + cq * 4; dd[0] = rintf(v[i][0] * inv[0]); dd[1] = rintf(v[i][1] * inv[1]); dd[2] = rintf(v[i][2] * inv[2]); dd[3] = rintf(v[i][3] * inv[3]); }
        __syncthreads();
        if (kt + 1 < DM / 64) {
#pragma unroll
            for (int i = 0; i < 2; ++i) v[i] = *(const f32x4*)(W + (size_t)((kt + 1) * 64 + r0 + 32 * i) * N + n0 + cq * 4);
        }
        { const LAS float* s = scr + (kc * 8) * 65 + n;
          unsigned lo = 0, hi = 0;
#pragma unroll
          for (int e = 0; e < 4; ++e) { lo |= ((unsigned)(int)s[e * 65] & 0xffu) << (8 * e); hi |= ((unsigned)(int)s[(4 + e) * 65] & 0xffu) << (8 * e); }
          *(u32x2*)(WQ + (size_t)(n0 + n) * DM + kt * 64 + kc * 8) = (u32x2){lo, hi}; }
        __syncthreads();
    }
}
__device__ __forceinline__ void phase_conv(const Params& p, LAS unsigned char* lds, int wg, int G) {
    LAS float* scr = (LAS float*)lds;
    const int tid = opaque_tid();
    {
        constexpr int T_IN = (DM / 64) * (DIN / 256), T_AB = (HW / 64) * (DM / 256), T_SQ = (DM / 64) * (DM / 256);
        int base = 0;
        tr_loop(p.w_in, (bf16_t*)(p.ws + WS_WINT), DIN, DM, 0, T_IN, (((wg - base) % G) + G) % G, G, scr, tid); base += T_IN;
        tr_loop(p.w_a, (bf16_t*)(p.ws + WS_WAT), DM, 2 * HW, 0, T_AB, (((wg - base) % G) + G) % G, G, scr, tid); base += T_AB;
        tr_loop(p.w_b, (bf16_t*)(p.ws + WS_WAT), DM, 2 * HW, HW, T_AB, (((wg - base) % G) + G) % G, G, scr, tid); base += T_AB;
        tr_loop(p.w_out, (bf16_t*)(p.ws + WS_WOT), DM, DM, 0, T_SQ, (((wg - base) % G) + G) % G, G, scr, tid); base += T_SQ;
        tr_loop(p.peer_wq, (bf16_t*)(p.ws + WS_WQT), DM, DM, 0, T_SQ, (((wg - base) % G) + G) % G, G, scr, tid);
    }
    constexpr int I_SK = PH * 2 * NKEYS * 128 / 4096;
    constexpr int NITEMS = I_SK + 1;
    for (int it = wg; it < NITEMS; it += G) {
        int r = it;
        if (r < I_SK) { convert_chunk(p.subkeys, (bf16_t*)(p.ws + WS_SKB), (size_t)r * 4096, tid); continue; } r -= I_SK;
        float* lb = (float*)(p.ws + WS_LB);
        for (int j = tid; j < HW; j += NTHR) { const float l0 = p.lb_logits[j], l1 = p.lb_logits[HW + j]; lb[j] = 1.f / (1.f + __expf(l1 - l0)); }
    }
}

__device__ __forceinline__ void phase_vtab(const Params& p, int sub, int nsub) {
    const int tid = opaque_tid();
    for (int r = sub; r < NEXP / 8; r += nsub) {
#if V_FP4
        quantize_row_fp4(p.peer_v, p.ws + WS_VQ, (float*)(p.ws + WS_VSC), r * 8 + (tid >> 6), tid & 63);
#elif V_FP6
        quantize_row_fp6(p.peer_v, p.ws + WS_VQ, (float*)(p.ws + WS_VSC), r * 8 + (tid >> 6), tid & 63);
#else
        quantize_row_fp8(p.peer_v, p.ws + WS_VQ, (float*)(p.ws + WS_VSC), r * 8 + (tid >> 6), tid & 63);
#endif
    }
}

__device__ __forceinline__ void quant_rows_bf16(const bf16_t* wt, unsigned char* wq, float* sws, int nrows, int wg, int G, int w, int lane) {
    for (int row = wg * 8 + w; row < nrows; row += G * 8) {
        float v[32]; float am = 0.f;
#pragma unroll
        for (int j = 0; j < 2; ++j)
#pragma unroll
            for (int q = 0; q < 2; ++q) {
                const u32x4 r = *(const u32x4*)(wt + (size_t)row * DM + 1024 * j + 16 * lane + 8 * q);
                float* vp = v + 16 * j + 8 * q;
                vp[0] = bf_lo(r.x); vp[1] = bf_hi(r.x); vp[2] = bf_lo(r.y); vp[3] = bf_hi(r.y); vp[4] = bf_lo(r.z); vp[5] = bf_hi(r.z); vp[6] = bf_lo(r.w); vp[7] = bf_hi(r.w);
            }
#pragma unroll
        for (int i = 0; i < 32; ++i) am = fmaxf(am, fabsf(v[i]));
        am = wave_max_nonneg(am);
        const float sc_ = am > 0.f ? am * (1.f / 127.f) : 1.f, inv = am > 0.f ? 127.f / am : 0.f;
        if (lane == 0) sws[row] = sc_;
#pragma unroll
        for (int j = 0; j < 2; ++j) {
            unsigned wd[4];
#pragma unroll
            for (int q = 0; q < 4; ++q) { unsigned x4 = 0;
#pragma unroll
                for (int e = 0; e < 4; ++e) { const int qi = (int)rintf(v[16 * j + 4 * q + e] * inv); x4 |= ((unsigned)qi & 0xffu) << (8 * e); }
                wd[q] = x4; }
            *(u32x4*)(wq + (size_t)row * DM + 1024 * j + 16 * lane) = (u32x4){wd[0], wd[1], wd[2], wd[3]};
        }
    }
}
__device__ __forceinline__ void phase_hmod(const Params& p, int wg, int G) {
    const int tid = opaque_tid(), w = tid >> 6, lane = tid & 63;
    const float* mod = (const float*)(p.ws + WS_MOD);
    unsigned char* hq = p.ws + WS_HBF; float* shs = (float*)(p.ws + WS_SH);
#pragma unroll 2
    for (int row = wg * 8 + w; row < NT; row += G * 8) {
        const int b = row / SEQ;
        f32x4 h[8]; float am = 0.f;
#pragma unroll
        for (int j = 0; j < 2; ++j)
#pragma unroll
            for (int q = 0; q < 4; ++q) {
                const int c = 1024 * j + 16 * lane + 4 * q;
                const f32x4 xv = *(const f32x4*)(p.x + (size_t)row * DM + c), sh = *(const f32x4*)(mod + b * 6 * DM + c), sc = *(const f32x4*)(mod + b * 6 * DM + DM + c);
                h[4 * j + q] = xv * (1.f + sc) + sh;
                am = fmaxf(am, fmaxf(fmaxf(fabsf(h[4 * j + q][0]), fabsf(h[4 * j + q][1])), fmaxf(fabsf(h[4 * j + q][2]), fabsf(h[4 * j + q][3]))));
            }
        am = wave_max_nonneg(am);
        const float sc_ = am > 0.f ? am * (1.f / 127.f) : 1.f, inv = am > 0.f ? 127.f / am : 0.f;
        if (lane == 0) shs[row] = sc_;
#pragma unroll
        for (int j = 0; j < 2; ++j) {
            unsigned wd[4];
#pragma unroll
            for (int q = 0; q < 4; ++q) { unsigned x4 = 0;
#pragma unroll
                for (int e = 0; e < 4; ++e) { const int qi = (int)rintf(h[4 * j + q][e] * inv); x4 |= ((unsigned)qi & 0xffu) << (8 * e); }
                wd[q] = x4; }
            *(u32x4*)(hq + (size_t)row * DM + 1024 * j + 16 * lane) = (u32x4){wd[0], wd[1], wd[2], wd[3]};
        }
    }

    quant_rows_bf16((const bf16_t*)(p.ws + WS_WINT), p.ws + WS_WQ8, (float*)(p.ws + WS_SW), DIN, wg, G, w, lane);
    quant_rows_bf16((const bf16_t*)(p.ws + WS_WQT), p.ws + WS_WQ8B, (float*)(p.ws + WS_SWQ), DM, wg, G, w, lane);
}
namespace pg8 {
constexpr int BM = 256, BK = 64, HALF = 128, HTB = HALF * BK * 2, STAGE_BYTES = 8 * HTB, NXCD = 8, WGM = 8;
__host__ __device__ __forceinline__ int lds_byte(int r, int c) { const int st = (r >> 4) * 2 + (c >> 5), rr = r & 15, cc = c & 31, ob = rr * 64 + cc * 2; return st * 1024 + (ob ^ (((ob >> 9) & 1) << 5)); }
__host__ __device__ __forceinline__ void stage_rc(int b, int& R, int& C) { const int st = b / 1024, sb = b % 1024, swz = sb ^ (((sb >> 9) & 1) << 5); R = (st >> 1) * 16 + swz / 64; C = (st & 1) * 32 + (swz % 64) / 2; }
__host__ __device__ __forceinline__ int perm32(int rho) { const int n = rho >> 4, i = rho & 15; return 8 * (i >> 2) + 4 * n + (i & 3); }
struct Unit { int pm, pn; };
struct Gemm { const bf16_t* A; const bf16_t* Bt; int M, N, K; };
struct StaticOrder {
    int nM, nN, nwg, G, c;
    __host__ __device__ void init(int M, int N, int G_, int c_) { nM = M / BM; nN = N / BM; nwg = nM * nN; G = G_; c = c_; }
    __host__ __device__ bool next(int i, Unit& u) const {
        const long L = (long)i * G + c; if (L >= nwg) return false;
        int wgid = (int)L; { const int q = nwg / NXCD, r = nwg % NXCD, xcd = wgid % NXCD, off = wgid / NXCD; wgid = (xcd < r ? xcd * (q + 1) : r * (q + 1) + (xcd - r) * q) + off; }
        const int nig = WGM * nN, gid = wgid / nig, fm = gid * WGM, gsz = (nM - fm) < WGM ? (nM - fm) : WGM;
        u.pm = fm + ((wgid % nig) % gsz); u.pn = (wgid % nig) / gsz; return true;
    }
};
template <class Epi, class Sched>
__device__ __forceinline__ void gemm_phase(LAS unsigned char* lds, const Gemm g, const Sched& S, const Epi& E) {
    const int tid = opaque_tid(), wid = __builtin_amdgcn_readfirstlane(tid >> 6), lane = tid & 63, wr = wid >> 2, wc = wid & 3, fr = lane & 15, fq = lane >> 4;
    const int K = g.K, nt = K / BK;
    unsigned voffA[2], voffB[2];
#pragma unroll
    for (int i = 0; i < 2; ++i) { int R, C; stage_rc(tid * 16 + i * 8192, R, C); const int Rb = Epi::PERM ? ((R & ~31) + perm32(R & 31)) : R;
        voffA[i] = (unsigned)(R * K + C) * 2u; voffB[i] = (unsigned)(Rb * K + C) * 2u; }
    const size_t kstep = (size_t)(BK * 2);
    const size_t hstep = (size_t)HALF * K * 2;
    const size_t tstep = 2 * hstep;
    const unsigned ldsw = (unsigned)wid * 1024u;
    const int aoff = lds_byte(wr * 64 + fr, fq * 8), boff = lds_byte(wc * 32 + fr, fq * 8);
#define PG8_SA(b, h) (((b) * 2 + (h)) * HTB)
#define PG8_SB(b, h) ((4 + (b) * 2 + (h)) * HTB)
#define PG8_STAGE(bufoff, gbase, voff) do { _Pragma("unroll") for (int _i = 0; _i < 2; ++_i) \
        __builtin_amdgcn_global_load_lds((const unsigned*)((const char*)(gbase) + (voff)[_i]), (LAS unsigned*)(lds + (bufoff) + ldsw + _i * 8192), 16, 0, 0); } while (0)
#define PG8_LDA(dst, b, h) do { _Pragma("unroll") for (int m = 0; m < 4; ++m) _Pragma("unroll") for (int k = 0; k < 2; ++k) dst[m][k] = *(const LAS bf16x8*)(lds + PG8_SA(b, h) + aoff + m * 2048 + k * 1024); } while (0)
#define PG8_LDB(dst, b, h) do { _Pragma("unroll") for (int n = 0; n < 2; ++n) _Pragma("unroll") for (int k = 0; k < 2; ++k) dst[n][k] = *(const LAS bf16x8*)(lds + PG8_SB(b, h) + boff + n * 2048 + k * 1024); } while (0)
#define PG8_MMA(ai, bj, At, Bt) do { __builtin_amdgcn_s_setprio(1); _Pragma("unroll") for (int m = 0; m < 4; ++m) _Pragma("unroll") for (int n = 0; n < 2; ++n) _Pragma("unroll") for (int k = 0; k < 2; ++k) \
        { if constexpr (Epi::I8) acc[ai][bj][m][n] = __builtin_bit_cast(acc_t, __builtin_amdgcn_mfma_i32_16x16x64_i8(__builtin_bit_cast(i32x4, Bt[n][k]), __builtin_bit_cast(i32x4, At[m][k]), __builtin_bit_cast(i32x4, acc[ai][bj][m][n]), 0, 0, 0)); \
          else acc[ai][bj][m][n] = __builtin_bit_cast(acc_t, __builtin_amdgcn_mfma_f32_16x16x32_bf16(Bt[n][k], At[m][k], __builtin_bit_cast(f32x4, acc[ai][bj][m][n]), 0, 0, 0)); } __builtin_amdgcn_s_setprio(0); } while (0)
#define PG8_WAIT_V(n) asm volatile("s_waitcnt vmcnt(" #n ")" ::: "memory")
#define PG8_WAIT_L(n) asm volatile("s_waitcnt lgkmcnt(" #n ")" ::: "memory")
#define PG8_BAR __builtin_amdgcn_s_barrier()
#define PG8_SCHED __builtin_amdgcn_sched_barrier(0)
    Unit cur, nxt; int ui = 0;
    if (!S.next(0, cur)) return;
    typedef typename Epi::acc_t acc_t;
    acc_t acc[2][2][4][2];
#pragma unroll
    for (int a = 0; a < 2; ++a)
#pragma unroll
        for (int b = 0; b < 2; ++b)
#pragma unroll
            for (int m = 0; m < 4; ++m)
#pragma unroll
                for (int n = 0; n < 2; ++n) acc[a][b][m][n] = (acc_t){0, 0, 0, 0};
    bf16x8 At[4][2], B0[2][2], B1[2][2];
    const char* cA = (const char*)g.A + (size_t)cur.pm * tstep; const char* cB = (const char*)g.Bt + (size_t)cur.pn * tstep;
    PG8_STAGE(PG8_SB(0, 0), cB, voffB); PG8_STAGE(PG8_SA(0, 0), cA, voffA); PG8_STAGE(PG8_SB(0, 1), cB + hstep, voffB); PG8_STAGE(PG8_SA(0, 1), cA + hstep, voffA);
    if (wr == 1) PG8_BAR;
    PG8_WAIT_V(4); PG8_BAR;
    PG8_STAGE(PG8_SB(1, 0), cB + kstep, voffB); PG8_STAGE(PG8_SA(1, 0), cA + kstep, voffA); PG8_STAGE(PG8_SB(1, 1), cB + hstep + kstep, voffB);
    PG8_WAIT_V(6); PG8_BAR;
    for (;;) {
        const bool has_next = S.next(ui + 1, nxt);
        const char* nA = has_next ? (const char*)g.A + (size_t)nxt.pm * tstep : cA; const char* nB = has_next ? (const char*)g.Bt + (size_t)nxt.pn * tstep : cB;
        for (int t = 0; t < nt; t += 2) {
            const bool last = (t == nt - 2);
            const char* a1 = cA + (size_t)(t + 1) * kstep;
            const char* a2 = last ? nA : cA + (size_t)(t + 2) * kstep; const char* b2 = last ? nB : cB + (size_t)(t + 2) * kstep;
            const char* a3 = a2 + kstep; const char* b3 = b2 + kstep;
            if constexpr (Epi::MID) { if (t == nt / 2) E.mid(acc, cur, wr, wc, fr, fq); }
            PG8_LDB(B0, 0, 0); PG8_SCHED; PG8_LDA(At, 0, 0); PG8_STAGE(PG8_SA(1, 1), a1 + hstep, voffA);
            PG8_WAIT_L(8); PG8_BAR; PG8_WAIT_L(0); PG8_MMA(0, 0, At, B0); PG8_BAR; PG8_SCHED;
            PG8_LDB(B1, 0, 1); PG8_STAGE(PG8_SB(0, 0), b2, voffB);
            PG8_BAR; PG8_WAIT_L(0); PG8_MMA(0, 1, At, B1); PG8_BAR;
            PG8_LDA(At, 0, 1); PG8_STAGE(PG8_SA(0, 0), a2, voffA);
            PG8_BAR; PG8_WAIT_L(0); PG8_MMA(1, 0, At, B0); PG8_BAR; PG8_SCHED;
            PG8_STAGE(PG8_SB(0, 1), b2 + hstep, voffB);
            PG8_WAIT_V(6); PG8_BAR; PG8_MMA(1, 1, At, B1); PG8_BAR;
            PG8_LDB(B0, 1, 0); PG8_SCHED; PG8_LDA(At, 1, 0); PG8_STAGE(PG8_SA(0, 1), a2 + hstep, voffA);
            PG8_WAIT_L(8); PG8_BAR; PG8_WAIT_L(0); PG8_MMA(0, 0, At, B0); PG8_BAR; PG8_SCHED;
            PG8_LDB(B1, 1, 1); PG8_STAGE(PG8_SB(1, 0), b3, voffB);
            PG8_BAR; PG8_WAIT_L(0); PG8_MMA(0, 1, At, B1); PG8_BAR;
            PG8_LDA(At, 1, 1); PG8_STAGE(PG8_SA(1, 0), a3, voffA);
            PG8_BAR; PG8_WAIT_L(0); PG8_MMA(1, 0, At, B0); PG8_BAR; PG8_SCHED;
            PG8_STAGE(PG8_SB(1, 1), b3 + hstep, voffB);
            PG8_WAIT_V(6); PG8_BAR; PG8_MMA(1, 1, At, B1); PG8_BAR;
        }
        E(acc, cur, wr, wc, fr, fq);
        if (!has_next) break;
#pragma unroll
        for (int a = 0; a < 2; ++a)
#pragma unroll
            for (int b = 0; b < 2; ++b)
#pragma unroll
                for (int m = 0; m < 4; ++m)
#pragma unroll
                    for (int n = 0; n < 2; ++n) acc[a][b][m][n] = (acc_t){0, 0, 0, 0};
        cur = nxt; cA = nA; cB = nB; ++ui;
    }
    PG8_WAIT_V(0);
    if (wr == 0) PG8_BAR;
    PG8_BAR;
#undef PG8_SA
#undef PG8_SB
#undef PG8_STAGE
#undef PG8_LDA
#undef PG8_LDB
#undef PG8_MMA
#undef PG8_WAIT_V
#undef PG8_WAIT_L
#undef PG8_BAR
#undef PG8_SCHED
}
}

struct EpiProj {
    typedef i32x4 acc_t; static constexpr bool PERM = true, MID = false, I8 = true;
    unsigned char* ws;
    __device__ __forceinline__ void operator()(const i32x4 (&iacc)[2][2][4][2], const pg8::Unit& u, int wr, int wc, int fr, int fq) const {
        const int row0 = u.pm * 256 + wr * 64 + fr, pn = u.pn;
        f32x4 acc[2][2][4][2];
        { const float* shs = (const float*)(ws + WS_SH); const float* sws = (const float*)(ws + WS_SW);
          f32x4 cw[2][2];
#pragma unroll
          for (int bj = 0; bj < 2; ++bj)
#pragma unroll
              for (int n = 0; n < 2; ++n) cw[bj][n] = *(const f32x4*)(sws + pn * 256 + bj * 128 + wc * 32 + 8 * fq + 4 * n);
#pragma unroll
          for (int ai = 0; ai < 2; ++ai)
#pragma unroll
              for (int m = 0; m < 4; ++m) { const float rs = shs[row0 + ai * 128 + m * 16];
#pragma unroll
                  for (int bj = 0; bj < 2; ++bj)
#pragma unroll
                      for (int n = 0; n < 2; ++n)
#pragma unroll
                          for (int j = 0; j < 4; ++j) acc[ai][bj][m][n][j] = (float)iacc[ai][bj][m][n][j] * rs * cw[bj][n][j]; } }
        const int cin = wc * 32 + 8 * fq;
        int seg, cbase;
        if (pn < 28) { seg = pn >> 2; cbase = (pn & 3) * 256; } else if (pn < 36) { seg = 7; cbase = (pn - 28) * 256; } else { seg = 8; cbase = (pn - 36) * 256; }
        if (seg == 2) {
            bf16_t* vt = (bf16_t*)(ws + WS_VT);
#pragma unroll
            for (int ai = 0; ai < 2; ++ai)
#pragma unroll
                for (int m = 0; m < 4; ++m) {
                    const int row = row0 + ai * 128 + m * 16, b = row / SEQ, s = row % SEQ;
#pragma unroll
                    for (int bj = 0; bj < 2; ++bj) {
                        const int c = cbase + bj * 128 + cin, h = c >> 7, d = c & 127;
                        bf16_t* dst = vt + ((size_t)((b * NH + h) * HD + d)) * SEQ + s;
#pragma unroll
                        for (int n = 0; n < 2; ++n)
#pragma unroll
                            for (int j = 0; j < 4; ++j) dst[(size_t)(n * 4 + j) * SEQ] = f2bf(acc[ai][bj][m][n][j]);
                    }
                }
            return;
        }
        bf16_t* base; int ldc;
        switch (seg) {
            case 0: base = (bf16_t*)(ws + WS_Q); ldc = HW; break;
            case 1: base = (bf16_t*)(ws + WS_K); ldc = HW; break;
            case 3: base = (bf16_t*)(ws + WS_HQ); ldc = HW; break;
            case 4: base = (bf16_t*)(ws + WS_HF); ldc = HW; break;
            case 5: base = (bf16_t*)(ws + WS_HI); ldc = HW; break;
            case 6: base = (bf16_t*)(ws + WS_HG); ldc = HW; break;
            case 7: base = (bf16_t*)(ws + WS_GA); ldc = DM; break;
            default: base = (bf16_t*)(ws + WS_GB); ldc = DM; break;
        }
        const float qs = 0.08838834764831845f * LOG2E;
#pragma unroll
        for (int ai = 0; ai < 2; ++ai)
#pragma unroll
            for (int m = 0; m < 4; ++m) {
                bf16_t* rowp = base + (size_t)(row0 + ai * 128 + m * 16) * ldc + cbase + cin;
#pragma unroll
                for (int bj = 0; bj < 2; ++bj) {
                    f32x4 v0 = acc[ai][bj][m][0], v1 = acc[ai][bj][m][1];
                    if (seg == 0) { v0 *= qs; v1 *= qs; }
                    else if (seg == 6) {
#pragma unroll
                        for (int j = 0; j < 4; ++j) { v0[j] = siluf_(v0[j]); v1[j] = siluf_(v1[j]); }
                    } else if (seg >= 7) {
#pragma unroll
                        for (int j = 0; j < 4; ++j) { v0[j] = sigmoidf_(v0[j]); v1[j] = sigmoidf_(v1[j]); }
                    }
                    u32x4 w; w.x = pk2(v0[0], v0[1]); w.y = pk2(v0[2], v0[3]); w.z = pk2(v1[0], v1[1]); w.w = pk2(v1[2], v1[3]);
                    *(u32x4*)(rowp + bj * 128) = w;
                }
            }
    }
};
struct EpiT1 {
    typedef f32x4 acc_t; static constexpr bool PERM = true, MID = false, I8 = false;
    unsigned char* ws;
    __device__ __forceinline__ void operator()(const f32x4 (&acc)[2][2][4][2], const pg8::Unit& u, int wr, int wc, int fr, int fq) const {
        const int row0 = u.pm * 256 + wr * 64 + fr, col0 = u.pn * 256 + wc * 32 + 8 * fq;
        const bf16_t* ga = (const bf16_t*)(ws + WS_GA); float* t1 = (float*)(ws + WS_R1);
#pragma unroll
        for (int ai = 0; ai < 2; ++ai)
#pragma unroll
            for (int m = 0; m < 4; ++m)
#pragma unroll
                for (int bj = 0; bj < 2; ++bj) {
                    const size_t off = (size_t)(row0 + ai * 128 + m * 16) * DM + col0 + bj * 128;
                    const u32x4 g = *(const u32x4*)(ga + off);
                    f32x4 v0 = acc[ai][bj][m][0], v1 = acc[ai][bj][m][1];
                    v0[0] *= bf_lo(g.x); v0[1] *= bf_hi(g.x); v0[2] *= bf_lo(g.y); v0[3] *= bf_hi(g.y);
                    v1[0] *= bf_lo(g.z); v1[1] *= bf_hi(g.z); v1[2] *= bf_lo(g.w); v1[3] *= bf_hi(g.w);
                    *(f32x4*)(t1 + off) = v0; *(f32x4*)(t1 + off + 4) = v1;
                }
    }
};
struct EpiMerge {
    typedef f32x4 acc_t; static constexpr bool PERM = true, MID = false, I8 = false;
    unsigned char* ws;
    __device__ __forceinline__ void operator()(const f32x4 (&acc)[2][2][4][2], const pg8::Unit& u, int wr, int wc, int fr, int fq) const {
        const int row0 = u.pm * 256 + wr * 64 + fr, col0 = u.pn * 256 + wc * 32 + 8 * fq;
        const bf16_t* gb = (const bf16_t*)(ws + WS_GB); const float* t1 = (const float*)(ws + WS_R1); bf16_t* mg = (bf16_t*)(ws + WS_MERGED);
#pragma unroll
        for (int ai = 0; ai < 2; ++ai)
#pragma unroll
            for (int m = 0; m < 4; ++m)
#pragma unroll
                for (int bj = 0; bj < 2; ++bj) {
                    const size_t off = (size_t)(row0 + ai * 128 + m * 16) * DM + col0 + bj * 128;
                    const u32x4 g = *(const u32x4*)(gb + off);
                    f32x4 v0 = acc[ai][bj][m][0], v1 = acc[ai][bj][m][1];
                    const f32x4 t0 = *(const f32x4*)(t1 + off), t4 = *(const f32x4*)(t1 + off + 4);
                    v0[0] = v0[0] * bf_lo(g.x) + t0[0]; v0[1] = v0[1] * bf_hi(g.x) + t0[1]; v0[2] = v0[2] * bf_lo(g.y) + t0[2]; v0[3] = v0[3] * bf_hi(g.y) + t0[3];
                    v1[0] = v1[0] * bf_lo(g.z) + t4[0]; v1[1] = v1[1] * bf_hi(g.z) + t4[1]; v1[2] = v1[2] * bf_lo(g.w) + t4[2]; v1[3] = v1[3] * bf_hi(g.w) + t4[3];
                    u32x4 w; w.x = pk2(v0[0], v0[1]); w.y = pk2(v0[2], v0[3]); w.z = pk2(v1[0], v1[1]); w.w = pk2(v1[2], v1[3]);
                    *(u32x4*)(mg + off) = w;
                }
    }
};
struct EpiRes1 {
    typedef f32x4 acc_t; static constexpr bool PERM = true, MID = false, I8 = false;
    unsigned char* ws; const float* x;
    __device__ __forceinline__ void operator()(const f32x4 (&acc)[2][2][4][2], const pg8::Unit& u, int wr, int wc, int fr, int fq) const {
        const int row0 = u.pm * 256 + wr * 64 + fr, col0 = u.pn * 256 + wc * 32 + 8 * fq;
        const float* mod = (const float*)(ws + WS_MOD); bf16_t* r1 = (bf16_t*)(ws + WS_R1);
        const int b = (u.pm * 256) / SEQ;
        f32x4 g1[2][2];
#pragma unroll
        for (int bj = 0; bj < 2; ++bj)
#pragma unroll
            for (int n = 0; n < 2; ++n) g1[bj][n] = 1.f + *(const f32x4*)(mod + b * 6 * DM + 2 * DM + col0 + bj * 128 + 4 * n);
#pragma unroll
        for (int ai = 0; ai < 2; ++ai)
#pragma unroll
            for (int m = 0; m < 4; ++m) {
                const size_t ro = (size_t)(row0 + ai * 128 + m * 16) * DM + col0;
#pragma unroll
                for (int bj = 0; bj < 2; ++bj) {
                    const f32x4 x0 = *(const f32x4*)(x + ro + bj * 128), x1 = *(const f32x4*)(x + ro + bj * 128 + 4);
                    const f32x4 v0 = ALPHA * x0 + g1[bj][0] * acc[ai][bj][m][0], v1 = ALPHA * x1 + g1[bj][1] * acc[ai][bj][m][1];
                    u32x4 w; w.x = pk2(v0[0], v0[1]); w.y = pk2(v0[2], v0[3]); w.z = pk2(v1[0], v1[1]); w.w = pk2(v1[2], v1[3]);
                    *(u32x4*)(r1 + ro + bj * 128) = w;
                }
            }
    }
};
struct EpiQP {
    typedef f32x4 acc_t; static constexpr bool PERM = true, MID = false, I8 = false;
    unsigned char* ws;
    __device__ __forceinline__ void operator()(const f32x4 (&acc)[2][2][4][2], const pg8::Unit& u, int wr, int wc, int fr, int fq) const {
        const int row0 = u.pm * 256 + wr * 64 + fr, col0 = u.pn * 256 + wc * 32 + 8 * fq;
        bf16_t* qp = (bf16_t*)(ws + WS_QP);
#pragma unroll
        for (int ai = 0; ai < 2; ++ai)
#pragma unroll
            for (int m = 0; m < 4; ++m)
#pragma unroll
                for (int bj = 0; bj < 2; ++bj) {
                    const size_t off = (size_t)(row0 + ai * 128 + m * 16) * DM + col0 + bj * 128;
                    const f32x4 v0 = acc[ai][bj][m][0], v1 = acc[ai][bj][m][1];
                    u32x4 w; w.x = pk2(v0[0], v0[1]); w.y = pk2(v0[2], v0[3]); w.z = pk2(v1[0], v1[1]); w.w = pk2(v1[2], v1[3]);
                    *(u32x4*)(qp + off) = w;
                }
    }
};

struct EpiMerge2 {
    typedef f32x4 acc_t; static constexpr bool PERM = true, MID = true, I8 = false;
    unsigned char* ws;
    __device__ __forceinline__ void mid(f32x4 (&acc)[2][2][4][2], const pg8::Unit& u, int wr, int wc, int fr_in, int fq) const {
        int fr = fr_in; asm volatile("" : "+v"(fr));
        const int row0 = u.pm * 256 + wr * 64 + fr, col0 = u.pn * 256 + wc * 32 + 8 * fq;
        const bf16_t* ga = (const bf16_t*)(ws + WS_GA); const bf16_t* gb = (const bf16_t*)(ws + WS_GB);
#pragma unroll
        for (int ai = 0; ai < 2; ++ai)
#pragma unroll
            for (int m = 0; m < 4; ++m)
#pragma unroll
                for (int bj = 0; bj < 2; ++bj) {
                    const size_t off = (size_t)(row0 + ai * 128 + m * 16) * DM + col0 + bj * 128;
                    const u32x4 a = *(const u32x4*)(ga + off), b = *(const u32x4*)(gb + off);
                    const unsigned aw[4] = {a.x, a.y, a.z, a.w}, bw[4] = {b.x, b.y, b.z, b.w};
#pragma unroll
                    for (int q = 0; q < 4; ++q) {
                        const float r0 = bf_lo(aw[q]) * fast_rcp(fmaxf(bf_lo(bw[q]), 1e-20f)), r1 = bf_hi(aw[q]) * fast_rcp(fmaxf(bf_hi(bw[q]), 1e-20f));
                        acc[ai][bj][m][q >> 1][2 * (q & 1)] *= r0; acc[ai][bj][m][q >> 1][2 * (q & 1) + 1] *= r1;
                    }
                    asm volatile("" ::: "memory");
                }
    }
    __device__ __forceinline__ void operator()(const f32x4 (&acc)[2][2][4][2], const pg8::Unit& u, int wr, int wc, int fr, int fq) const {
        const int row0 = u.pm * 256 + wr * 64 + fr, col0 = u.pn * 256 + wc * 32 + 8 * fq;
        const bf16_t* gb = (const bf16_t*)(ws + WS_GB); bf16_t* mg = (bf16_t*)(ws + WS_MERGED);
#pragma unroll
        for (int ai = 0; ai < 2; ++ai)
#pragma unroll
            for (int m = 0; m < 4; ++m)
#pragma unroll
                for (int bj = 0; bj < 2; ++bj) {
                    const size_t off = (size_t)(row0 + ai * 128 + m * 16) * DM + col0 + bj * 128;
                    const u32x4 g = *(const u32x4*)(gb + off);
                    const f32x4 v0 = acc[ai][bj][m][0], v1 = acc[ai][bj][m][1];
                    u32x4 w;
                    w.x = pk2(v0[0] * fmaxf(bf_lo(g.x), 1e-20f), v0[1] * fmaxf(bf_hi(g.x), 1e-20f)); w.y = pk2(v0[2] * fmaxf(bf_lo(g.y), 1e-20f), v0[3] * fmaxf(bf_hi(g.y), 1e-20f));
                    w.z = pk2(v1[0] * fmaxf(bf_lo(g.z), 1e-20f), v1[1] * fmaxf(bf_hi(g.z), 1e-20f)); w.w = pk2(v1[2] * fmaxf(bf_lo(g.w), 1e-20f), v1[3] * fmaxf(bf_hi(g.w), 1e-20f));
                    *(u32x4*)(mg + off) = w;
                }
    }
};

struct EpiQP8 {
    typedef i32x4 acc_t; static constexpr bool PERM = true, MID = false, I8 = true;
    unsigned char* ws;
    __device__ __forceinline__ void operator()(const i32x4 (&acc)[2][2][4][2], const pg8::Unit& u, int wr, int wc, int fr, int fq) const {
        const int row0 = u.pm * 256 + wr * 64 + fr, col0 = u.pn * 256 + wc * 32 + 8 * fq;
        bf16_t* qp = (bf16_t*)(ws + WS_QP); const float* shs = (const float*)(ws + WS_SH2); const float* sws = (const float*)(ws + WS_SWQ);
        f32x4 cw[2][2];
#pragma unroll
        for (int bj = 0; bj < 2; ++bj)
#pragma unroll
            for (int n = 0; n < 2; ++n) cw[bj][n] = *(const f32x4*)(sws + col0 + bj * 128 + 4 * n);
#pragma unroll
        for (int ai = 0; ai < 2; ++ai)
#pragma unroll
            for (int m = 0; m < 4; ++m) {
                const float rs = shs[row0 + ai * 128 + m * 16];
#pragma unroll
                for (int bj = 0; bj < 2; ++bj) {
                    const size_t off = (size_t)(row0 + ai * 128 + m * 16) * DM + col0 + bj * 128;
                    float v[8];
#pragma unroll
                    for (int n = 0; n < 2; ++n)
#pragma unroll
                        for (int j = 0; j < 4; ++j) v[4 * n + j] = (float)acc[ai][bj][m][n][j] * rs * cw[bj][n][j];
                    u32x4 w; w.x = pk2(v[0], v[1]); w.y = pk2(v[2], v[3]); w.z = pk2(v[4], v[5]); w.w = pk2(v[6], v[7]);
                    *(u32x4*)(qp + off) = w;
                }
            }
    }
};
constexpr float ATT_EXIT = -150.f;
constexpr int ATT_KS_BYTES = 64 * 256, ATT_VT_STRIDE = 136, ATT_VT_BYTES = 128 * ATT_VT_STRIDE;
__device__ __forceinline__ void phase_attn(const Params& p, LAS unsigned char* lds, int wg, int G) {
    const int tid = opaque_tid(), w = __builtin_amdgcn_readfirstlane(tid >> 6), lane = tid & 63, l31 = lane & 31, h2 = lane >> 5;
    const bf16_t* Qg = (const bf16_t*)(p.ws + WS_Q); const bf16_t* Kg = (const bf16_t*)(p.ws + WS_K); const bf16_t* VTg = (const bf16_t*)(p.ws + WS_VT);
    bf16_t* AO = (bf16_t*)(p.ws + WS_AB);
    LAS unsigned char* KsB[2] = {lds, lds + ATT_KS_BYTES};
    LAS unsigned char* VtB[2] = {lds + 2 * ATT_KS_BYTES, lds + 2 * ATT_KS_BYTES + ATT_VT_BYTES};
    volatile LAS int* flags = (volatile LAS int*)(lds + 2 * ATT_KS_BYTES + 2 * ATT_VT_BYTES);
    for (int item = wg; item < NB * NH * 16; item += G) {
        const int bh = item >> 4, qb = item & 15, b = bh >> 3, h = bh & 7, t0 = qb * 256;
        const int tq = t0 + 32 * w + l31;
        const int tq_hi = t0 + 32 * w + 31;
        bf16x8 qf[8];
        { const bf16_t* qrow = Qg + (size_t)(b * SEQ + tq) * HW + h * HD + h2 * 8;
#pragma unroll
          for (int ks = 0; ks < 8; ++ks) qf[ks] = *(const bf16x8*)(qrow + ks * 16); }
        f32x16 o[4];
#pragma unroll
        for (int i = 0; i < 4; ++i)
#pragma unroll
            for (int r = 0; r < 16; ++r) o[i][r] = 0.f;
        float R = 0.f;
        bool wdone = false;
        const int kt_first = (t0 + 256) / 64 - 1;
        u32x4 kreg[2], vreg[2];
        const bf16_t* Kbase = Kg + (size_t)(b * SEQ) * HW + h * HD;
        const bf16_t* Vbase = VTg + (size_t)(bh * HD) * SEQ;
        auto prefetch = [&](int kt) {
#pragma unroll
            for (int i = 0; i < 2; ++i) {
                const int id = tid + i * NTHR;
                const int kr = id >> 4, kc = id & 15;
                kreg[i] = *(const u32x4*)(Kbase + (size_t)(kt * 64 + kr) * HW + kc * 8);
                const int vr = id >> 3, vc = id & 7;
                vreg[i] = *(const u32x4*)(Vbase + (size_t)vr * SEQ + kt * 64 + vc * 8);
            }
        };
        prefetch(kt_first);
        __syncthreads();
        if (tid < 16) flags[tid] = 0;
        int it = 0;
        for (int kt = kt_first; kt >= 0; --kt, ++it) {
            const int cur = it & 1;
#pragma unroll
            for (int i = 0; i < 2; ++i) {
                const int id = tid + i * NTHR;
                const int kr = id >> 4, kc = id & 15;
                *(LAS u32x4*)(KsB[cur] + kr * 256 + ((kc ^ (kr & 15)) << 4)) = kreg[i];
                const int vr = id >> 3, vc = id & 7;
                LAS unsigned char* vd = VtB[cur] + vr * ATT_VT_STRIDE + vc * 16;
                *(LAS u32x2*)vd = (u32x2){vreg[i].x, vreg[i].y}; *(LAS u32x2*)(vd + 8) = (u32x2){vreg[i].z, vreg[i].w};
            }
            __syncthreads();
            if (it > 0) {
                int alld = 1;
#pragma unroll
                for (int j = 0; j < 8; ++j) alld &= flags[((it - 1) & 1) * 8 + j];
                if (alld) break;
            }
            if (kt > 0) prefetch(kt - 1);
            const bool active = !wdone && (kt * 64 < tq_hi);
            if (active) {
#pragma unroll
                for (int kbi = 0; kbi < 2; ++kbi) {
                    const int kb = 1 - kbi;
                    const int key0 = kt * 64 + kb * 32;
                    if (key0 < tq_hi) {
                        f32x16 S;
#pragma unroll
                        for (int r = 0; r < 16; ++r) S[r] = 0.f;
                        const int krow = kb * 32 + l31;
                        const LAS unsigned char* kp = KsB[cur] + krow * 256;
#pragma unroll
                        for (int ks = 0; ks < 8; ++ks) {
                            const bf16x8 a = *(const LAS bf16x8*)(kp + (((ks * 2 + h2) ^ (krow & 15)) << 4));
                            S = __builtin_amdgcn_mfma_f32_32x32x16_bf16(a, qf[ks], S, 0, 0, 0);
                        }
                        float lg[16], zb[16];
#pragma unroll
                        for (int r = 0; r < 16; ++r) {
                            const int key = key0 + (r & 3) + 8 * (r >> 2) + 4 * h2;
                            const float z = S[r];
                            const float sp = fmaxf(z, 0.f) + fast_log2(1.f + fast_exp2(-fabsf(z)));
                            const bool valid = key < tq;
                            lg[r] = valid ? -sp : 0.f;
                            zb[r] = valid ? (z - sp) : -INFINITY;
                        }
                        float g[4], pg[4], tot[4];
#pragma unroll
                        for (int i = 0; i < 4; ++i) { g[i] = (lg[4 * i] + lg[4 * i + 1]) + (lg[4 * i + 2] + lg[4 * i + 3]); pg[i] = __shfl_xor(g[i], 32); tot[i] = g[i] + pg[i]; }
                        float above[4]; above[3] = 0.f; above[2] = tot[3]; above[1] = tot[3] + tot[2]; above[0] = above[1] + tot[1];
                        unsigned wp[8];
#pragma unroll
                        for (int i = 0; i < 4; ++i) {
                            const float off = R + above[i] + (h2 == 0 ? pg[i] : 0.f);
                            const float c3 = off, c2 = c3 + lg[4 * i + 3], c1 = c2 + lg[4 * i + 2], c0 = c1 + lg[4 * i + 1];
                            const float w0 = fast_exp2(zb[4 * i] + c0), w1 = fast_exp2(zb[4 * i + 1] + c1), w2 = fast_exp2(zb[4 * i + 2] + c2), w3 = fast_exp2(zb[4 * i + 3] + c3);
                            wp[2 * i] = pk2(w0, w1); wp[2 * i + 1] = pk2(w2, w3);
                        }
                        R += (tot[0] + tot[1]) + (tot[2] + tot[3]);
#pragma unroll
                        for (int s2 = 0; s2 < 2; ++s2) {
                            bf16x8 bw;
                            { u32x4 t; t.x = wp[4 * s2]; t.y = wp[4 * s2 + 1]; t.z = wp[4 * s2 + 2]; t.w = wp[4 * s2 + 3]; bw = __builtin_bit_cast(bf16x8, t); }
                            const int kk = kb * 32 + 16 * s2 + 4 * h2;
#pragma unroll
                            for (int db = 0; db < 4; ++db) {
                                const LAS unsigned char* vp = VtB[cur] + (db * 32 + l31) * ATT_VT_STRIDE + kk * 2;
                                const u32x2 lo = *(const LAS u32x2*)vp, hi = *(const LAS u32x2*)(vp + 16);
                                u32x4 t; t.x = lo.x; t.y = lo.y; t.z = hi.x; t.w = hi.y;
                                o[db] = __builtin_amdgcn_mfma_f32_32x32x16_bf16(__builtin_bit_cast(bf16x8, t), bw, o[db], 0, 0, 0);
                            }
                        }
                    }
                }
                if (__all(R < ATT_EXIT)) wdone = true;
            }
            if (lane == 0) flags[cur * 8 + w] = wdone ? 1 : 0;
        }
        { bf16_t* orow = AO + (size_t)(b * SEQ + tq) * DM + h * HD;
#pragma unroll
          for (int db = 0; db < 4; ++db)
#pragma unroll
              for (int i = 0; i < 4; ++i) {
                  u32x2 v; v.x = pk2(o[db][4 * i], o[db][4 * i + 1]); v.y = pk2(o[db][4 * i + 2], o[db][4 * i + 3]);
                  *(u32x2*)(orow + db * 32 + 8 * i + 4 * h2) = v;
              } }
    }
    __syncthreads();
}

constexpr int HG_SEGC = 4, HG_NSEG = 16;
constexpr int HG_OFF_AS = 0, HG_OFF_KP = HG_OFF_AS + 64 * 272, HG_OFF_KT = HG_OFF_KP + 64 * 272, HG_OFF_VT = HG_OFF_KT + 128 * 144,
              HG_OFF_PS = HG_OFF_VT + 128 * 144, HG_OFF_ST = HG_OFF_PS + 64 * 144, HG_OFF_GAM = HG_OFF_ST + 128 * 272,
              HG_OFF_RS = HG_OFF_GAM + 512, HG_OFF_GSEG = HG_OFF_RS + 512, HG_OFF_LBS = HG_OFF_GSEG + 512, HG_LDS_END = HG_OFF_LBS + 512;
template <int PASS>
__device__ __forceinline__ void phase_hgrn(const Params& p, LAS unsigned char* lds, int wg, int G) {
    const int tid = opaque_tid(), w = __builtin_amdgcn_readfirstlane(tid >> 6), lane = tid & 63, fr = lane & 15, fq = lane >> 4;
    LAS unsigned char* As = lds + HG_OFF_AS; LAS unsigned char* Kp = lds + HG_OFF_KP; LAS unsigned char* KT = lds + HG_OFF_KT;
    LAS unsigned char* VT = lds + HG_OFF_VT; LAS unsigned char* Ps = lds + HG_OFF_PS; LAS unsigned char* ST = lds + HG_OFF_ST;
    LAS float* gam = (LAS float*)(lds + HG_OFF_GAM); LAS float* rs = (LAS float*)(lds + HG_OFF_RS);
    LAS float* gseg = (LAS float*)(lds + HG_OFF_GSEG); LAS float* lbs = (LAS float*)(lds + HG_OFF_LBS);
    const bf16_t* HQ = (const bf16_t*)(p.ws + WS_HQ); const bf16_t* HF = (const bf16_t*)(p.ws + WS_HF); const bf16_t* HI = (const bf16_t*)(p.ws + WS_HI);
    const bf16_t* HGs = (const bf16_t*)(p.ws + WS_HG); bf16_t* BO = (bf16_t*)(p.ws + WS_AB) + HW;
    const float* lbv = (const float*)(p.ws + WS_LB);
    float* HST = (float*)(p.ws + WS_HST); float* HGAM = (float*)(p.ws + WS_HGAM);
    for (int item = wg; item < NB * NH * HG_NSEG; item += G) {
        const int bh = item / HG_NSEG, seg = item % HG_NSEG, b = bh >> 3, h = bh & 7;
        f32x4 S[8];
#pragma unroll
        for (int eb = 0; eb < 8; ++eb) S[eb] = (f32x4){0.f, 0.f, 0.f, 0.f};
        __syncthreads();
        u32x4 pq[2], pf[2], pv[2];
        { const int tokf = b * SEQ + (seg * HG_SEGC) * 64;
#pragma unroll
          for (int i = 0; i < 2; ++i) {
              const size_t go = (size_t)(tokf + lane) * HW + h * HD + (w + 8 * i) * 8;
              pq[i] = *(const u32x4*)(HQ + go); pf[i] = *(const u32x4*)(HF + go); pv[i] = *(const u32x4*)(HI + go);
          } }
        if (tid < 128) { lbs[tid] = lbv[h * HD + tid]; if (PASS == 0) gseg[tid] = 1.f; }
        if (PASS == 1) {
            f32x4 P4 = {1.f, 1.f, 1.f, 1.f};
            for (int j = seg - 1; j >= 0; --j) {
                const float* Lj = HST + (size_t)(bh * HG_NSEG + j) * (HD * HD);
#pragma unroll
                for (int eb = 0; eb < 8; ++eb)
#pragma unroll
                    for (int jj = 0; jj < 4; ++jj) S[eb][jj] += P4[jj] * Lj[(size_t)(w * 16 + 4 * fq + jj) * HD + eb * 16 + fr];
                P4 *= *(const f32x4*)(HGAM + (size_t)(bh * HG_NSEG + j) * HD + w * 16 + 4 * fq);
                if (__all(P4[0] == 0.f && P4[1] == 0.f && P4[2] == 0.f && P4[3] == 0.f)) break;
            }
#pragma unroll
            for (int eb = 0; eb < 8; ++eb) { u32x2 v; v.x = pk2(S[eb][0], S[eb][1]); v.y = pk2(S[eb][2], S[eb][3]); *(LAS u32x2*)(ST + (eb * 16 + fr) * 272 + (w * 16 + 4 * fq) * 2) = v; }
        }
        f32x4 urv[8];
        { const int urow0 = PASS * (NEXP / 2) + item * (HG_SEGC * 8) + w; if (urow0 < NEXP) utab_load(p, urow0, lane, urv); }
        f32x4 ngv[4];
        if (PASS == 1) {
#pragma unroll
            for (int q = 0; q < 4; ++q) ngv[q] = *(const f32x4*)(p.hg_norm_g + h * HD + (((w & 1) * 4 + q) * 16 + 4 * fq));
        }
        __syncthreads();
        for (int cc = 0; cc < HG_SEGC; ++cc) {
            const int tok0 = b * SEQ + (seg * HG_SEGC + cc) * 64;
            const int urow = PASS * (NEXP / 2) + item * (HG_SEGC * 8) + cc * 8 + w;
            u32x2 ggv[4];
            if (PASS == 1) {
                const int tg_ = tok0 + (w >> 1) * 16 + fr;
#pragma unroll
                for (int q = 0; q < 4; ++q) ggv[q] = *(const u32x2*)(HGs + (size_t)tg_ * HW + h * HD + (((w & 1) * 4 + q) * 16 + 4 * fq));
            }
#pragma unroll
            for (int i = 0; i < 2; ++i) {
                const int t = lane, c8 = w + 8 * i;
                const u32x4 qv = pq[i], fv = pf[i], vv = pv[i];
                const unsigned qa[4] = {qv.x, qv.y, qv.z, qv.w}, fa[4] = {fv.x, fv.y, fv.z, fv.w}, va[4] = {vv.x, vv.y, vv.z, vv.w};
                float av[8], kp[8];
#pragma unroll
                for (int j = 0; j < 8; ++j) {
                    const int d = c8 * 8 + j;
                    const float fp = (j & 1) ? bf_hi(fa[j >> 1]) : bf_lo(fa[j >> 1]);
                    const float lb = lbs[d];
                    const float f = lb + (1.f - lb) * sigmoidf_(fp);
                    float c = f;
                    c *= __int_as_float(__builtin_amdgcn_update_dpp(0x3f800000, __float_as_int(c), 0x111, 0xf, 0xf, false));
                    c *= __int_as_float(__builtin_amdgcn_update_dpp(0x3f800000, __float_as_int(c), 0x112, 0xf, 0xf, false));
                    c *= __int_as_float(__builtin_amdgcn_update_dpp(0x3f800000, __float_as_int(c), 0x114, 0xf, 0xf, false));
                    c *= __int_as_float(__builtin_amdgcn_update_dpp(0x3f800000, __float_as_int(c), 0x118, 0xf, 0xf, false));
                    { const float t0 = __int_as_float(__builtin_amdgcn_readlane(__float_as_int(c), 15)), t1 = __int_as_float(__builtin_amdgcn_readlane(__float_as_int(c), 31)),
                                  t2 = __int_as_float(__builtin_amdgcn_readlane(__float_as_int(c), 47));
                      const float t01 = t0 * t1, t012 = t01 * t2;
                      c *= (lane < 16) ? 1.f : (lane < 32) ? t0 : (lane < 48) ? t01 : t012; }
                    const float cl = __int_as_float(__builtin_amdgcn_readlane(__float_as_int(c), 63));
                    const float r = fast_rcp(fmaxf(c, 1e-30f)), kv = 1.f - f;
                    const float qf = (j & 1) ? bf_hi(qa[j >> 1]) : bf_lo(qa[j >> 1]);
                    av[j] = qf * c; kp[j] = kv * r;
                    *(LAS bf16_t*)(KT + d * 144 + t * 2) = f2bf(kp[j] * cl);
                    const unsigned vb = (j & 1) ? (va[j >> 1] >> 16) : (va[j >> 1] & 0xffffu);
                    *(LAS bf16_t*)(VT + d * 144 + t * 2) = (bf16_t)vb;
                    if (lane == 0) { gam[d] = cl; if (PASS == 0) gseg[d] *= cl; }
                }
                u32x4 o1, o2; o1.x = pk2(av[0], av[1]); o1.y = pk2(av[2], av[3]); o1.z = pk2(av[4], av[5]); o1.w = pk2(av[6], av[7]);
                o2.x = pk2(kp[0], kp[1]); o2.y = pk2(kp[2], kp[3]); o2.z = pk2(kp[4], kp[5]); o2.w = pk2(kp[6], kp[7]);
                if (PASS == 1) { *(LAS u32x4*)(As + t * 272 + c8 * 16) = o1; *(LAS u32x4*)(Kp + t * 272 + c8 * 16) = o2; }
            }
            if (cc + 1 < HG_SEGC) {
#pragma unroll
                for (int i = 0; i < 2; ++i) {
                    const size_t go = (size_t)(tok0 + 64 + lane) * HW + h * HD + (w + 8 * i) * 8;
                    pq[i] = *(const u32x4*)(HQ + go); pf[i] = *(const u32x4*)(HF + go); pv[i] = *(const u32x4*)(HI + go);
                }
            }
            if (urow < NEXP) utab_quant_store(p, urow, lane, urv);
            if (cc + 1 < HG_SEGC && urow + 8 < NEXP) utab_load(p, urow + 8, lane, urv);
            __syncthreads();
            if (PASS == 1) {
                { const int tb = w >> 1;
#pragma unroll
                  for (int q = 0; q < 2; ++q) {
                      const int sb = (w & 1) * 2 + q;
                      f32x4 c = {0.f, 0.f, 0.f, 0.f};
#pragma unroll
                      for (int ks = 0; ks < 4; ++ks) {
                          const bf16x8 a = *(const LAS bf16x8*)(Kp + (sb * 16 + fr) * 272 + (ks * 32 + fq * 8) * 2);
                          const bf16x8 bb = *(const LAS bf16x8*)(As + (tb * 16 + fr) * 272 + (ks * 32 + fq * 8) * 2);
                          c = __builtin_amdgcn_mfma_f32_16x16x32_bf16(a, bb, c, 0, 0, 0);
                      }
                      const int t = tb * 16 + fr, s0 = sb * 16 + 4 * fq;
                      u32x2 v; v.x = pk2(s0 <= t ? c[0] : 0.f, s0 + 1 <= t ? c[1] : 0.f); v.y = pk2(s0 + 2 <= t ? c[2] : 0.f, s0 + 3 <= t ? c[3] : 0.f);
                      *(LAS u32x2*)(Ps + t * 144 + s0 * 2) = v;
                  } }
                __syncthreads();
                { const int tb = w >> 1, eh = w & 1;
                  f32x4 oc[4];
#pragma unroll
                  for (int q = 0; q < 4; ++q) oc[q] = (f32x4){0.f, 0.f, 0.f, 0.f};
#pragma unroll
                  for (int ks = 0; ks < 2; ++ks) {
                      const bf16x8 bb = *(const LAS bf16x8*)(Ps + (tb * 16 + fr) * 144 + (ks * 32 + fq * 8) * 2);
#pragma unroll
                      for (int q = 0; q < 4; ++q) {
                          const bf16x8 a = *(const LAS bf16x8*)(VT + ((eh * 4 + q) * 16 + fr) * 144 + (ks * 32 + fq * 8) * 2);
                          oc[q] = __builtin_amdgcn_mfma_f32_16x16x32_bf16(a, bb, oc[q], 0, 0, 0);
                      }
                  }
#pragma unroll
                  for (int ks = 0; ks < 4; ++ks) {
                      const bf16x8 bb = *(const LAS bf16x8*)(As + (tb * 16 + fr) * 272 + (ks * 32 + fq * 8) * 2);
#pragma unroll
                      for (int q = 0; q < 4; ++q) {
                          const bf16x8 a = *(const LAS bf16x8*)(ST + ((eh * 4 + q) * 16 + fr) * 272 + (ks * 32 + fq * 8) * 2);
                          oc[q] = __builtin_amdgcn_mfma_f32_16x16x32_bf16(a, bb, oc[q], 0, 0, 0);
                      }
                  }
                  float ss = 0.f;
#pragma unroll
                  for (int q = 0; q < 4; ++q) ss += (oc[q][0] * oc[q][0] + oc[q][1] * oc[q][1]) + (oc[q][2] * oc[q][2] + oc[q][3] * oc[q][3]);
                  ss += __shfl_xor(ss, 16); ss += __shfl_xor(ss, 32);
                  if (fq == 0) rs[eh * 64 + tb * 16 + fr] = ss;
                  __syncthreads();
                  const float tot = rs[tb * 16 + fr] + rs[64 + tb * 16 + fr];
                  const float rstd = rsqrtf(tot * (1.f / 128.f) + RMS_EPS);
                  const int tg = tok0 + tb * 16 + fr;
#pragma unroll
                  for (int q = 0; q < 4; ++q) {
                      const int e = (eh * 4 + q) * 16 + 4 * fq;
                      const f32x4 ng = ngv[q];
                      const u32x2 gg = ggv[q];
                      u32x2 v;
                      v.x = pk2(oc[q][0] * rstd * ng[0] * bf_lo(gg.x), oc[q][1] * rstd * ng[1] * bf_hi(gg.x));
                      v.y = pk2(oc[q][2] * rstd * ng[2] * bf_lo(gg.y), oc[q][3] * rstd * ng[3] * bf_hi(gg.y));
                      *(u32x2*)(BO + (size_t)tg * DM + h * HD + e) = v;
                  }
                }
            }
            { const f32x4 g4 = *(const LAS f32x4*)(gam + w * 16 + 4 * fq);
              bf16x8 a[2];
#pragma unroll
              for (int ks = 0; ks < 2; ++ks) a[ks] = *(const LAS bf16x8*)(KT + (w * 16 + fr) * 144 + (ks * 32 + fq * 8) * 2);
#pragma unroll
              for (int eb = 0; eb < 8; ++eb) {
                  f32x4 c = S[eb] * g4;
#pragma unroll
                  for (int ks = 0; ks < 2; ++ks) {
                      const bf16x8 bb = *(const LAS bf16x8*)(VT + (eb * 16 + fr) * 144 + (ks * 32 + fq * 8) * 2);
                      c = __builtin_amdgcn_mfma_f32_16x16x32_bf16(a[ks], bb, c, 0, 0, 0);
                  }
                  S[eb] = c;
              } }
            __syncthreads();
            if (PASS == 1) {
#pragma unroll
                for (int eb = 0; eb < 8; ++eb) { u32x2 v; v.x = pk2(S[eb][0], S[eb][1]); v.y = pk2(S[eb][2], S[eb][3]); *(LAS u32x2*)(ST + (eb * 16 + fr) * 272 + (w * 16 + 4 * fq) * 2) = v; }
            }
        }
        if (PASS == 0) {
            float* Ls = HST + (size_t)(bh * HG_NSEG + seg) * (HD * HD);
#pragma unroll
            for (int eb = 0; eb < 8; ++eb)
#pragma unroll
                for (int jj = 0; jj < 4; ++jj) Ls[(size_t)(w * 16 + 4 * fq + jj) * HD + eb * 16 + fr] = S[eb][jj];
            if (lane == 0) {
#pragma unroll
                for (int i = 0; i < 2; ++i)
#pragma unroll
                    for (int j = 0; j < 8; ++j) HGAM[(size_t)(bh * HG_NSEG + seg) * HD + (w + 8 * i) * 8 + j] = gseg[(w + 8 * i) * 8 + j];
            }
        }
    }
    __syncthreads();
}
__device__ __forceinline__ void phase_ln1(const Params& p, int wg, int G) {
    const int tid = opaque_tid(), w = tid >> 6, lane = tid & 63;
    const bf16_t* r1 = (const bf16_t*)(p.ws + WS_R1); const float* mod = (const float*)(p.ws + WS_MOD);
    unsigned char* h2q = p.ws + WS_H2; float* sh2 = (float*)(p.ws + WS_SH2); float* st = (float*)(p.ws + WS_STAT1);
#pragma unroll 2
    for (int row = wg * 8 + w; row < NT; row += G * 8) {
        const int b = row / SEQ;
        f32x4 v[8]; float s = 0.f;
#pragma unroll
        for (int j = 0; j < 2; ++j)
#pragma unroll
            for (int q = 0; q < 2; ++q) { const u32x4 r = *(const u32x4*)(r1 + (size_t)row * DM + 1024 * j + 16 * lane + 8 * q);
                v[4 * j + 2 * q] = (f32x4){bf_lo(r.x), bf_hi(r.x), bf_lo(r.y), bf_hi(r.y)}; v[4 * j + 2 * q + 1] = (f32x4){bf_lo(r.z), bf_hi(r.z), bf_lo(r.w), bf_hi(r.w)};
                s += ((v[4 * j + 2 * q][0] + v[4 * j + 2 * q][1]) + (v[4 * j + 2 * q][2] + v[4 * j + 2 * q][3])) + ((v[4 * j + 2 * q + 1][0] + v[4 * j + 2 * q + 1][1]) + (v[4 * j + 2 * q + 1][2] + v[4 * j + 2 * q + 1][3])); }
        const float mean = wave_sum(s) * (1.f / DM);
        float s2 = 0.f;
#pragma unroll
        for (int i = 0; i < 8; ++i) { v[i] = v[i] - mean; s2 += (v[i][0] * v[i][0] + v[i][1] * v[i][1]) + (v[i][2] * v[i][2] + v[i][3] * v[i][3]); }
        const float rstd = rsqrtf(wave_sum(s2) * (1.f / DM) + LN_EPS);
        if (lane == 0) { st[row * 2] = mean; st[row * 2 + 1] = rstd; }
        float am = 0.f;
#pragma unroll
        for (int j = 0; j < 2; ++j)
#pragma unroll
            for (int q = 0; q < 4; ++q) {
                const int c = 1024 * j + 16 * lane + 4 * q;
                const f32x4 g = *(const f32x4*)(p.ln1_g + c), bb = *(const f32x4*)(p.ln1_b + c);
                const f32x4 sh = *(const f32x4*)(mod + b * 6 * DM + 3 * DM + c), sc = *(const f32x4*)(mod + b * 6 * DM + 4 * DM + c);
                const f32x4 hh = (v[4 * j + q] * rstd * g + bb) * (1.f + sc) + sh;
                v[4 * j + q] = hh;
                am = fmaxf(am, fmaxf(fmaxf(fabsf(hh[0]), fabsf(hh[1])), fmaxf(fabsf(hh[2]), fabsf(hh[3]))));
            }
        am = wave_max_nonneg(am);
        const float sc_ = am > 0.f ? am * (1.f / 127.f) : 1.f, inv = am > 0.f ? 127.f / am : 0.f;
        if (lane == 0) sh2[row] = sc_;
#pragma unroll
        for (int j = 0; j < 2; ++j) {
            unsigned wd[4];
#pragma unroll
            for (int q = 0; q < 4; ++q) { unsigned x4 = 0;
#pragma unroll
                for (int e = 0; e < 4; ++e) { const int qi = (int)rintf(v[4 * j + q][e] * inv); x4 |= ((unsigned)qi & 0xffu) << (8 * e); }
                wd[q] = x4; }
            *(u32x4*)(h2q + (size_t)row * DM + 1024 * j + 16 * lane) = (u32x4){wd[0], wd[1], wd[2], wd[3]};
        }
    }
}

__device__ __forceinline__ unsigned f2ord(float f) { const unsigned u = __float_as_uint(f); return (u & 0x80000000u) ? ~u : (u | 0x80000000u); }
__device__ __forceinline__ unsigned wave_max_u32(unsigned v) {
#pragma unroll
    for (int o = 1; o < 64; o <<= 1) { const unsigned t = (unsigned)__shfl_xor((int)v, o); v = t > v ? t : v; }
    return v;
}
constexpr int RT_OFF_TBL = 65536, RT_LDS_END = RT_OFF_TBL + 8 * 8192;
__device__ __forceinline__ void ins16(float (&L)[16], float x) {
#pragma unroll
    for (int i = 15; i >= 1; --i) L[i] = __builtin_amdgcn_fmed3f(L[i - 1], L[i], x);
    L[0] = fmaxf(L[0], x);
}
__device__ __forceinline__ void phase_route(const Params& p, LAS unsigned char* lds, int wg, int G, int only_h = -1, int only_tb = 0) {
    const int tid = opaque_tid(), w = __builtin_amdgcn_readfirstlane(tid >> 6), lane = tid & 63, l31 = lane & 31, h2 = lane >> 5;
    const bf16_t* QP = (const bf16_t*)(p.ws + WS_QP); const bf16_t* SK = (const bf16_t*)(p.ws + WS_SKB);
    int* RIDX = (int*)(p.ws + WS_RIDX); float* RGATE = (float*)(p.ws + WS_RGATE); float* RUS = (float*)(p.ws + WS_RUS);
    const float* USC = (const float*)(p.ws + WS_USC); const float* VSC = (const float*)(p.ws + WS_VSC);
    LAS float* tbl = (LAS float*)(lds + RT_OFF_TBL + w * 8192);
    for (int item = (only_h >= 0 ? 0 : wg); item < (only_h >= 0 ? 1 : PH * (NT / 256)); item += G) {
        const int h = only_h >= 0 ? only_h : item / (NT / 256), tb = only_h >= 0 ? only_tb : item % (NT / 256);
        __syncthreads();
#pragma unroll
        for (int i = 0; i < 8; ++i) {
            const int id = tid + i * NTHR, row = id >> 4, c16 = id & 15;
            *(LAS u32x4*)(lds + row * 256 + ((c16 ^ (row & 15)) << 4)) = *(const u32x4*)(SK + ((size_t)h * 256 + row) * 128 + c16 * 8);
        }
        __syncthreads();
        const int t = tb * 256 + w * 32 + l31;
#pragma unroll 1
        for (int pp = 0; pp < 2; ++pp) {
            bf16x8 qf[8];
            { const bf16_t* qrow = QP + (size_t)t * DM + h * 256 + pp * 128 + h2 * 8;
#pragma unroll
              for (int ks = 0; ks < 8; ++ks) qf[ks] = *(const bf16x8*)(qrow + ks * 16); }
            float L[16];
#pragma unroll
            for (int i = 0; i < 16; ++i) L[i] = -INFINITY;
#pragma unroll 1
            for (int nb = 0; nb < 4; ++nb) {
                f32x16 S;
#pragma unroll
                for (int r = 0; r < 16; ++r) S[r] = 0.f;
                const int row = pp * 128 + nb * 32 + l31;
#pragma unroll
                for (int ks = 0; ks < 8; ++ks) {
                    const bf16x8 a = *(const LAS bf16x8*)(lds + row * 256 + (((ks * 2 + h2) ^ (row & 15)) << 4));
                    S = __builtin_amdgcn_mfma_f32_32x32x16_bf16(a, qf[ks], S, 0, 0, 0);
                }
#pragma unroll
                for (int r = 0; r < 16; ++r) {
                    const unsigned n = (unsigned)(nb * 32 + (r & 3) + 8 * (r >> 2) + 4 * h2);
                    ins16(L, __uint_as_float((__float_as_uint(S[r]) & ~127u) | n));
                }
            }
            float P[16];
#pragma unroll
            for (int i = 0; i < 16; ++i) P[i] = __shfl_xor(L[i], 32);
#pragma unroll
            for (int i = 0; i < 16; ++i) ins16(L, P[i]);
#pragma unroll
            for (int i = 0; i < 16; ++i) tbl[(pp * 16 + i) * 64 + lane] = L[i];
        }
        float L0[16], L1[16];
#pragma unroll
        for (int i = 0; i < 16; ++i) { L0[i] = tbl[i * 64 + lane]; L1[i] = tbl[(16 + i) * 64 + lane]; }
        float C[16];
#pragma unroll
        for (int i = 0; i < 16; ++i) C[i] = -INFINITY;
#pragma unroll
        for (int a = 0; a < 16; ++a)
#pragma unroll
            for (int b = 0; b < 16; ++b)
                if ((a + 1) * (b + 1) <= 16) ins16(C, __uint_as_float((__float_as_uint(L0[a] + L1[b]) & ~255u) | (unsigned)(a * 16 + b)));
        const float vmax = C[0];
        float den = 0.f, ex[16];
#pragma unroll
        for (int i = 0; i < 16; ++i) { ex[i] = __expf(C[i] - vmax); den += ex[i]; }
        const float rden = 1.f / den;
        int* ip = RIDX + (size_t)t * 128 + h * 16 + h2 * 8; float* gp = RGATE + (size_t)t * 128 + h * 16 + h2 * 8; float* up = RUS + (size_t)t * 128 + h * 16 + h2 * 8;
        int eo[16]; float go[16], uo[16];
#pragma unroll
        for (int j = 0; j < 16; ++j) {
            const unsigned cb = __float_as_uint(C[j]), a = (cb >> 4) & 15u, b = cb & 15u;
            const unsigned i0 = __float_as_uint(tbl[a * 64 + lane]) & 127u, i1 = __float_as_uint(tbl[(16 + b) * 64 + lane]) & 127u;
            eo[j] = (int)(i0 * NKEYS + i1);
        }
#pragma unroll
        for (int j = 0; j < 16; ++j) { go[j] = ex[j] * rden * VSC[eo[j]]; uo[j] = USC[eo[j]]; }
        if (h2 == 0) {
            *(int4*)ip = make_int4(eo[0], eo[1], eo[2], eo[3]); *(int4*)(ip + 4) = make_int4(eo[4], eo[5], eo[6], eo[7]);
            *(f32x4*)gp = (f32x4){go[0], go[1], go[2], go[3]}; *(f32x4*)(gp + 4) = (f32x4){go[4], go[5], go[6], go[7]};
            *(f32x4*)up = (f32x4){uo[0], uo[1], uo[2], uo[3]}; *(f32x4*)(up + 4) = (f32x4){uo[4], uo[5], uo[6], uo[7]};
        } else {
            *(int4*)ip = make_int4(eo[8], eo[9], eo[10], eo[11]); *(int4*)(ip + 4) = make_int4(eo[12], eo[13], eo[14], eo[15]);
            *(f32x4*)gp = (f32x4){go[8], go[9], go[10], go[11]}; *(f32x4*)(gp + 4) = (f32x4){go[12], go[13], go[14], go[15]};
            *(f32x4*)up = (f32x4){uo[8], uo[9], uo[10], uo[11]}; *(f32x4*)(up + 4) = (f32x4){uo[12], uo[13], uo[14], uo[15]};
        }
    }
    __syncthreads();
}

__device__ __forceinline__ float gelu_exact(float v) { return 0.5f * v * (1.f + erff(v * 0.70710678118654752f)); }
__device__ __forceinline__ float ub0(unsigned w) { return (float)(w & 0xffu); }
__device__ __forceinline__ float ub1(unsigned w) { return (float)((w >> 8) & 0xffu); }
__device__ __forceinline__ float ub2(unsigned w) { return (float)((w >> 16) & 0xffu); }
__device__ __forceinline__ float ub3(unsigned w) { return (float)(w >> 24); }
#if U_FP6
constexpr int PE_OFF_XQ = 0, PE_OFF_KEYS = 131072, PE_OFF_XS = 147456, PE_OFF_WT = 0, PE_OFF_PW = 16384, PE_LDS_END = PE_OFF_XS + 256;
#else
constexpr int PE_OFF_XQ = 0, PE_OFF_KEYS = 65536, PE_OFF_WT = 81920, PE_OFF_PW = 98304, PE_OFF_XS = 114688, PE_LDS_END = PE_OFF_XS + 256;
#endif
constexpr int PE_VB = 16;
__device__ __forceinline__ void peer_axpy(f32x2 (&a)[16], float wgt, const u32x4 (&v)[2]) {
    const f32x2 w2 = {wgt, wgt};
#pragma unroll
    for (int j = 0; j < 2; ++j) {
        const unsigned r[4] = {v[j].x, v[j].y, v[j].z, v[j].w};
#pragma unroll
        for (int q = 0; q < 4; ++q) {
            a[8 * j + 2 * q] += w2 * __builtin_amdgcn_cvt_pk_f32_fp8((int)r[q], false);
            a[8 * j + 2 * q + 1] += w2 * __builtin_amdgcn_cvt_pk_f32_fp8((int)r[q], true);
        }
    }
}
__device__ __forceinline__ void peer_axpy6(f32x2 (&a)[16], float wgt, const u32x4& va, const u32x2& vb) {
    const f32x2 w2 = {wgt, wgt};
    const u32x6v pk = {va.x, va.y, va.z, va.w, vb.x, vb.y};
    const f32x32v y = __builtin_amdgcn_cvt_scalef32_pk32_f32_fp6(pk, 1.0f);
#pragma unroll
    for (int i = 0; i < 16; ++i) a[i] += w2 * (f32x2){y[2 * i], y[2 * i + 1]};
}
__device__ __forceinline__ void peer_axpy4(f32x2 (&a)[16], float wgt, const u32x4& va) {
    const f32x2 w2 = {wgt, wgt};
    const unsigned r[4] = {va.x, va.y, va.z, va.w};
#pragma unroll
    for (int q = 0; q < 4; ++q) {
        a[4 * q + 0] += w2 * __builtin_amdgcn_cvt_scalef32_pk_f32_fp4(r[q], 1.0f, 0);
        a[4 * q + 1] += w2 * __builtin_amdgcn_cvt_scalef32_pk_f32_fp4(r[q], 1.0f, 1);
        a[4 * q + 2] += w2 * __builtin_amdgcn_cvt_scalef32_pk_f32_fp4(r[q], 1.0f, 2);
        a[4 * q + 3] += w2 * __builtin_amdgcn_cvt_scalef32_pk_f32_fp4(r[q], 1.0f, 3);
    }
}
__device__ __forceinline__ void peer_ln2_store(const Params& p, f32x2 (&acc2)[16], int t, int lane_in) {
    int lane = lane_in; asm volatile("" : "+v"(lane));
    const bf16_t* r1 = (const bf16_t*)(p.ws + WS_R1); const float* st = (const float*)(p.ws + WS_STAT1); const float* mod = (const float*)(p.ws + WS_MOD);
    const int b = t / SEQ;
    float acc[32];
#pragma unroll
    for (int i = 0; i < 16; ++i) { acc[2 * i] = acc2[i].x; acc[2 * i + 1] = acc2[i].y; }
    const float mean1 = st[t * 2], rstd1 = st[t * 2 + 1];
    float s = 0.f;
#pragma unroll
    for (int j = 0; j < 2; ++j)
#pragma unroll
        for (int q = 0; q < 4; ++q) {
            const int c = 1024 * j + 16 * lane + 4 * q;
            const u32x2 rb = *(const u32x2*)(r1 + (size_t)t * DM + c); const f32x4 rv = {bf_lo(rb.x), bf_hi(rb.x), bf_lo(rb.y), bf_hi(rb.y)}, g = *(const f32x4*)(p.ln1_g + c), bb = *(const f32x4*)(p.ln1_b + c);
            const f32x4 g2 = *(const f32x4*)(mod + b * 6 * DM + 5 * DM + c);
#pragma unroll
            for (int k = 0; k < 4; ++k) {
                const float x1 = (rv[k] - mean1) * rstd1 * g[k] + bb[k];
                const float val = ALPHA * x1 + (1.f + g2[k]) * acc[16 * j + 4 * q + k];
                acc[16 * j + 4 * q + k] = val; s += val;
            }
            asm volatile("" ::: "memory");
        }
    const float mean = wave_sum(s) * (1.f / DM);
    float s2 = 0.f;
#pragma unroll
    for (int i = 0; i < 32; ++i) { acc[i] -= mean; s2 += acc[i] * acc[i]; }
    const float rstd = rsqrtf(wave_sum(s2) * (1.f / DM) + LN_EPS);
#pragma unroll
    for (int j = 0; j < 2; ++j)
#pragma unroll
        for (int q = 0; q < 4; ++q) {
            const int c = 1024 * j + 16 * lane + 4 * q;
            const f32x4 g = *(const f32x4*)(p.ln2_g + c), bb = *(const f32x4*)(p.ln2_b + c);
            f32x4 o;
#pragma unroll
            for (int k = 0; k < 4; ++k) o[k] = acc[16 * j + 4 * q + k] * rstd * g[k] + bb[k];
            *(f32x4*)(p.out + (size_t)t * DM + c) = o;
            asm volatile("" ::: "memory");
        }
}
__device__ __forceinline__ void phase_peer(const Params& p, LAS unsigned char* lds, int wg, int G) {
    const int tid = opaque_tid(), w = __builtin_amdgcn_readfirstlane(tid >> 6), lane = tid & 63;
    const unsigned char* UQ = p.ws + WS_UQ; const unsigned char* VQ = p.ws + WS_VQ;
    const int* RIDX = (const int*)(p.ws + WS_RIDX); const float* RGATE = (const float*)(p.ws + WS_RGATE); const float* RUS = (const float*)(p.ws + WS_RUS);
    LAS unsigned char* XQ = lds + PE_OFF_XQ; LAS unsigned* KEYS = (LAS unsigned*)(lds + PE_OFF_KEYS); LAS float* WT = (LAS float*)(lds + PE_OFF_WT);
    LAS unsigned* PW = (LAS unsigned*)(lds + PE_OFF_PW) + w * 512; LAS float* XS = (LAS float*)(lds + PE_OFF_XS);
    for (int item = wg; item < NT / 32; item += G) {
        const int t0 = item * 32;
        __syncthreads();
#pragma unroll
        for (int k = 0; k < 4; ++k) {
            const int tl = 4 * w + k;
            const unsigned char* src = (p.ws + WS_H2) + (size_t)(t0 + tl) * DM + 16 * lane;
#if U_FP6
            {
                const u32x4 s0 = *(const u32x4*)src, s1 = *(const u32x4*)(src + 1024);
#pragma unroll
                for (int hlf = 0; hlf < 2; ++hlf) {
                    const u32x4 sv = hlf ? s1 : s0; unsigned o[8];
#pragma unroll
                    for (int q = 0; q < 4; ++q) {
                        const unsigned uw = sv[q] ^ 0x80808080u;
                        const f16x2v lo = {(_Float16)(ub0(uw) - 128.f), (_Float16)(ub1(uw) - 128.f)};
                        const f16x2v hi = {(_Float16)(ub2(uw) - 128.f), (_Float16)(ub3(uw) - 128.f)};
                        o[2 * q] = __builtin_bit_cast(unsigned, lo); o[2 * q + 1] = __builtin_bit_cast(unsigned, hi);
                    }
                    LAS unsigned char* xd = XQ + tl * 4096 + 2048 * hlf + 32 * lane;
                    *(LAS u32x4*)xd = (u32x4){o[0], o[1], o[2], o[3]}; *(LAS u32x4*)(xd + 16) = (u32x4){o[4], o[5], o[6], o[7]};
                }
            }
#else
            *(LAS u32x4*)(XQ + tl * DM + 16 * lane) = *(const u32x4*)src; *(LAS u32x4*)(XQ + tl * DM + 1024 + 16 * lane) = *(const u32x4*)(src + 1024);
#endif
            if (lane == 0) XS[tl] = ((const float*)(p.ws + WS_SH2))[t0 + tl];
        }
#pragma unroll
        for (int k = 0; k < 8; ++k) { const int idx = tid + NTHR * k; KEYS[idx] = ((unsigned)RIDX[(size_t)t0 * 128 + idx] << 12) | (unsigned)idx; }
        __syncthreads();
        for (int k = 2; k <= 4096; k <<= 1)
            for (int j = k >> 1; j > 0; j >>= 1) {
#pragma unroll
                for (int qq = 0; qq < 4; ++qq) {
                    const int q = tid + NTHR * qq, lo = ((q & ~(j - 1)) << 1) | (q & (j - 1)), hi = lo | j;
                    const unsigned a = KEYS[lo], b = KEYS[hi];
                    const bool up = (lo & k) == 0;
                    if ((a > b) == up) { KEYS[lo] = b; KEYS[hi] = a; }
                }
                __syncthreads();
            }
#if U_FP6
        float wreg[8];
#pragma unroll
        for (int j = 0; j < 8; ++j) wreg[j] = 0.f;
#pragma unroll 1
        for (int g = 0; g < 8; ++g) {
            int lane_u = lane; asm volatile("" : "+v"(lane_u));
            const unsigned mykey = KEYS[g * 512 + lane_u * 8 + w];
            const int e_l = (int)(mykey >> 12), ts_l = (int)(mykey & 4095u), tl_l = ts_l >> 7;
            float v0[64];
#pragma unroll
            for (int k = 0; k < 64; ++k) {
                const int ek = __builtin_amdgcn_readlane(e_l, k), tlk = __builtin_amdgcn_readlane(tl_l, k);
                const unsigned char* ur = UQ + (size_t)ek * UROW;
                const u32x4 u0 = *(const u32x4*)(ur + 16 * lane_u); const u32x2 u1 = *(const u32x2*)(ur + 1024 + 8 * lane_u);
                const LAS unsigned char* xr = XQ + tlk * 4096 + 32 * lane_u;
                const u32x4 x0 = *(const LAS u32x4*)xr, x1 = *(const LAS u32x4*)(xr + 16), x2 = *(const LAS u32x4*)(xr + 2048), x3 = *(const LAS u32x4*)(xr + 2048 + 16);
                const u32x6v pk = {u0.x, u0.y, u0.z, u0.w, u1.x, u1.y};
                const f16x32v y = __builtin_amdgcn_cvt_scalef32_pk32_f16_fp6(pk, 1.0f);
                const f16x8v h0 = __builtin_bit_cast(f16x8v, x0), h1 = __builtin_bit_cast(f16x8v, x1), h2 = __builtin_bit_cast(f16x8v, x2), h3 = __builtin_bit_cast(f16x8v, x3);
                float d = 0.f;
#pragma unroll
                for (int i = 0; i < 4; ++i) {
                    d = __builtin_amdgcn_fdot2((f16x2v){y[2 * i], y[2 * i + 1]}, (f16x2v){h0[2 * i], h0[2 * i + 1]}, d, false);
                    d = __builtin_amdgcn_fdot2((f16x2v){y[8 + 2 * i], y[8 + 2 * i + 1]}, (f16x2v){h1[2 * i], h1[2 * i + 1]}, d, false);
                    d = __builtin_amdgcn_fdot2((f16x2v){y[16 + 2 * i], y[16 + 2 * i + 1]}, (f16x2v){h2[2 * i], h2[2 * i + 1]}, d, false);
                    d = __builtin_amdgcn_fdot2((f16x2v){y[24 + 2 * i], y[24 + 2 * i + 1]}, (f16x2v){h3[2 * i], h3[2 * i + 1]}, d, false);
                }
                v0[k] = d;
            }
            float v1[32], v2[16], v3[8], v4[4], v5[2];
            { const bool bt = lane & 1;
#pragma unroll
              for (int i = 0; i < 32; ++i) { const float keep = bt ? v0[2 * i + 1] : v0[2 * i], send = bt ? v0[2 * i] : v0[2 * i + 1]; v1[i] = keep + __shfl_xor(send, 1); } }
            { const bool bt = lane & 2;
#pragma unroll
              for (int i = 0; i < 16; ++i) { const float keep = bt ? v1[2 * i + 1] : v1[2 * i], send = bt ? v1[2 * i] : v1[2 * i + 1]; v2[i] = keep + __shfl_xor(send, 2); } }
            { const bool bt = lane & 4;
#pragma unroll
              for (int i = 0; i < 8; ++i) { const float keep = bt ? v2[2 * i + 1] : v2[2 * i], send = bt ? v2[2 * i] : v2[2 * i + 1]; v3[i] = keep + __shfl_xor(send, 4); } }
            { const bool bt = lane & 8;
#pragma unroll
              for (int i = 0; i < 4; ++i) { const float keep = bt ? v3[2 * i + 1] : v3[2 * i], send = bt ? v3[2 * i] : v3[2 * i + 1]; v4[i] = keep + __shfl_xor(send, 8); } }
            { const bool bt = lane & 16;
#pragma unroll
              for (int i = 0; i < 2; ++i) { const float keep = bt ? v4[2 * i + 1] : v4[2 * i], send = bt ? v4[2 * i] : v4[2 * i + 1]; v5[i] = keep + __shfl_xor(send, 16); } }
            float tot;
            { const bool bt = lane & 32; const float keep = bt ? v5[1] : v5[0], send = bt ? v5[0] : v5[1]; tot = keep + __shfl_xor(send, 32); }
            const size_t eo = (size_t)t0 * 128 + ts_l;
            const float act = RUS[eo] * XS[tl_l] * tot;
            const float wv = RGATE[eo] * gelu_exact(act);
#pragma unroll
            for (int j = 0; j < 8; ++j) wreg[j] = (g == j) ? wv : wreg[j];
        }
        __syncthreads();
#pragma unroll
        for (int j = 0; j < 8; ++j) { const unsigned key = KEYS[j * 512 + lane * 8 + w]; WT[key & 4095u] = wreg[j]; }
        __syncthreads();
#else
#ifndef PEER_REP_U
#define PEER_REP_U 1
#endif
#pragma unroll 1
        for (int g = 0; g < 8 * PEER_REP_U; ++g) {
            int lane_u = lane; asm volatile("" : "+v"(lane_u));
            const unsigned mykey = KEYS[(g & 7) * 512 + lane_u * 8 + w];
            const int e_l = (int)(mykey >> 12), ts_l = (int)(mykey & 4095u), tl_l = ts_l >> 7;
            int v0[64];
#pragma unroll
            for (int k = 0; k < 64; ++k) {
                const int ek = __builtin_amdgcn_readlane(e_l, k), tlk = __builtin_amdgcn_readlane(tl_l, k);
                const unsigned char* ur = UQ + (size_t)ek * DM + 16 * lane_u;
                const u32x4 u0 = *(const u32x4*)ur, u1 = *(const u32x4*)(ur + 1024);
                const LAS unsigned char* xr = XQ + tlk * DM + 16 * lane_u;
                const u32x4 x0 = *(const LAS u32x4*)xr, x1 = *(const LAS u32x4*)(xr + 1024);
                int d = 0;
                d = __builtin_amdgcn_sdot4((int)u0.x, (int)x0.x, d, false); d = __builtin_amdgcn_sdot4((int)u0.y, (int)x0.y, d, false);
                d = __builtin_amdgcn_sdot4((int)u0.z, (int)x0.z, d, false); d = __builtin_amdgcn_sdot4((int)u0.w, (int)x0.w, d, false);
                d = __builtin_amdgcn_sdot4((int)u1.x, (int)x1.x, d, false); d = __builtin_amdgcn_sdot4((int)u1.y, (int)x1.y, d, false);
                d = __builtin_amdgcn_sdot4((int)u1.z, (int)x1.z, d, false); d = __builtin_amdgcn_sdot4((int)u1.w, (int)x1.w, d, false);
                v0[k] = d;
            }
            int v1[32], v2[16], v3[8], v4[4], v5[2];
            { const bool bt = lane & 1;
#pragma unroll
              for (int i = 0; i < 32; ++i) { const int keep = bt ? v0[2 * i + 1] : v0[2 * i], send = bt ? v0[2 * i] : v0[2 * i + 1]; v1[i] = keep + __shfl_xor(send, 1); } }
            { const bool bt = lane & 2;
#pragma unroll
              for (int i = 0; i < 16; ++i) { const int keep = bt ? v1[2 * i + 1] : v1[2 * i], send = bt ? v1[2 * i] : v1[2 * i + 1]; v2[i] = keep + __shfl_xor(send, 2); } }
            { const bool bt = lane & 4;
#pragma unroll
              for (int i = 0; i < 8; ++i) { const int keep = bt ? v2[2 * i + 1] : v2[2 * i], send = bt ? v2[2 * i] : v2[2 * i + 1]; v3[i] = keep + __shfl_xor(send, 4); } }
            { const bool bt = lane & 8;
#pragma unroll
              for (int i = 0; i < 4; ++i) { const int keep = bt ? v3[2 * i + 1] : v3[2 * i], send = bt ? v3[2 * i] : v3[2 * i + 1]; v4[i] = keep + __shfl_xor(send, 8); } }
            { const bool bt = lane & 16;
#pragma unroll
              for (int i = 0; i < 2; ++i) { const int keep = bt ? v4[2 * i + 1] : v4[2 * i], send = bt ? v4[2 * i] : v4[2 * i + 1]; v5[i] = keep + __shfl_xor(send, 16); } }
            int tot;
            { const bool bt = lane & 32; const int keep = bt ? v5[1] : v5[0], send = bt ? v5[0] : v5[1]; tot = keep + __shfl_xor(send, 32); }
            const size_t eo = (size_t)t0 * 128 + ts_l;
            const float act = RUS[eo] * XS[tl_l] * (float)tot;
            WT[ts_l] = RGATE[eo] * gelu_exact(act);
        }
        __syncthreads();
#endif
        { int base0 = 0, base1 = 256;
#pragma unroll 1
          for (int c = 0; c < 64; ++c) {
              const unsigned key = KEYS[c * 64 + lane];
              const bool mine = ((key >> 9) & 7u) == (unsigned)w, hi = (key >> 8) & 1u;
              const unsigned long long m0 = __ballot(mine && !hi), m1 = __ballot(mine && hi), lt = (1ull << lane) - 1ull;
              if (mine && !hi) PW[base0 + __popcll(m0 & lt)] = key;
              if (mine && hi) PW[base1 + __popcll(m1 & lt)] = key;
              base0 += __popcll(m0); base1 += __popcll(m1);
          } }
#ifndef PEER_REP_V
#define PEER_REP_V 1
#endif
#pragma unroll 1
        for (int half_ = 0; half_ < 2 * PEER_REP_V; ++half_) {
            const int half = half_ & 1;
            int lane_v = lane; asm volatile("" : "+v"(lane_v));
            f32x2 a0[16], a1[16];
#pragma unroll
            for (int i = 0; i < 16; ++i) { a0[i] = (f32x2){0.f, 0.f}; a1[i] = (f32x2){0.f, 0.f}; }
#if V_FP4
            u32x4 vr_[PE_VB]; float wg_[PE_VB]; int sel[PE_VB]; unsigned nk[PE_VB];
#define PV_ISSUE(q, KEY) { const unsigned key = (unsigned)__builtin_amdgcn_readfirstlane((int)(KEY)); \
                vr_[q] = *(const u32x4*)(VQ + (size_t)(key >> 12) * VROW + 16 * lane_v); \
                wg_[q] = __int_as_float(__builtin_amdgcn_readfirstlane(__float_as_int(WT[key & 4095u]))); sel[q] = (int)((key >> 7) & 1u); }
#pragma unroll
            for (int q = 0; q < PE_VB; ++q) nk[q] = PW[half * 256 + q];
#pragma unroll
            for (int q = 0; q < PE_VB; ++q) PV_ISSUE(q, nk[q])
#pragma unroll 1
            for (int i0 = 0; i0 < 256; i0 += PE_VB) {
                const int nb = half * 256 + (i0 + PE_VB < 256 ? i0 + PE_VB : 256 - PE_VB);
#pragma unroll
                for (int q = 0; q < PE_VB; ++q) nk[q] = PW[nb + q];
#pragma unroll
                for (int q = 0; q < PE_VB; ++q) {
                    if (sel[q] == 0) peer_axpy4(a0, wg_[q], vr_[q]);
                    else peer_axpy4(a1, wg_[q], vr_[q]);
                    PV_ISSUE(q, nk[q])
                }
            }
#undef PV_ISSUE
#else
#pragma unroll 1
            for (int i0 = 0; i0 < 256; i0 += PE_VB) {
                u32x4 vv[PE_VB][2]; float wg_[PE_VB]; int sel[PE_VB];
#pragma unroll
                for (int q = 0; q < PE_VB; ++q) {
                    const unsigned key = (unsigned)__builtin_amdgcn_readfirstlane((int)PW[half * 256 + i0 + q]);
#ifdef PEER_VPROBE
                    const unsigned char* vr = VQ + (size_t)((half_ >= 2) ? ((key >> 12) & 511u) : (key >> 12)) * DM + 16 * lane_v;
#else
                    const unsigned char* vr = VQ + (size_t)(key >> 12) * VROW + 16 * lane_v;
#endif
#if V_FP4
                    vv[q][0] = *(const u32x4*)vr; vv[q][1] = (u32x4){0u, 0u, 0u, 0u};
#elif V_FP6
                    vv[q][0] = *(const u32x4*)vr; { const u32x2 t2 = *(const u32x2*)(vr + 1024 - 8 * lane_v); vv[q][1] = (u32x4){t2.x, t2.y, 0u, 0u}; }
#else
                    vv[q][0] = *(const u32x4*)vr; vv[q][1] = *(const u32x4*)(vr + 1024);
#endif
                    wg_[q] = __int_as_float(__builtin_amdgcn_readfirstlane(__float_as_int(WT[key & 4095u]))); sel[q] = (int)((key >> 7) & 1u);
                }
#pragma unroll
                for (int q = 0; q < PE_VB; ++q) {
#if V_FP4
                    if (sel[q] == 0) peer_axpy4(a0, wg_[q], vv[q][0]);
                    else peer_axpy4(a1, wg_[q], vv[q][0]);
#elif V_FP6
                    if (sel[q] == 0) peer_axpy6(a0, wg_[q], vv[q][0], (u32x2){vv[q][1].x, vv[q][1].y});
                    else peer_axpy6(a1, wg_[q], vv[q][0], (u32x2){vv[q][1].x, vv[q][1].y});
#else
                    if (sel[q] == 0) peer_axpy(a0, wg_[q], vv[q]);
                    else peer_axpy(a1, wg_[q], vv[q]);
#endif
                }
            }
#endif
#ifdef PEER_VPROBE
            if (half_ >= 2) { asm volatile("" :: "v"(a0[0].x + a1[3].y)); continue; }
#endif
            peer_ln2_store(p, a0, t0 + 4 * w + 2 * half + 0, lane_v);
            peer_ln2_store(p, a1, t0 + 4 * w + 2 * half + 1, lane_v);
        }
    }
    __syncthreads();
}
constexpr int LDS_BAR_OFF = 153600, LDS_BYTES = LDS_BAR_OFF + 64;
static_assert(HG_LDS_END <= LDS_BAR_OFF && PE_LDS_END <= LDS_BAR_OFF && RT_LDS_END <= LDS_BAR_OFF && pg8::STAGE_BYTES <= LDS_BAR_OFF, "LDS map");
constexpr int N_PHASES = 11;
extern __shared__ __attribute__((aligned(16))) unsigned char smem_raw[];

template <int PH>
__device__ __forceinline__ void run_phase(const Params& p, LAS unsigned char* lds, int wg, int G) {
    if constexpr (PH == 0) { phase_ada(p, lds, wg, G); phase_conv(p, lds, wg, G); }
    if constexpr (PH == 1) { phase_hmod(p, wg, G); }
    if constexpr (PH == 2) { pg8::StaticOrder S; S.init(NT, DIN, G, wg); pg8::Gemm g{(const bf16_t*)(p.ws + WS_HBF), (const bf16_t*)(p.ws + WS_WQ8), NT, DIN, DM / 2}; EpiProj E{p.ws};
        const int rem = S.nwg % G; const bool shortwg = rem != 0 && wg >= rem, first = shortwg && ((wg >> 3) & 1);
        if (first) phase_vtab(p, wg - rem, G - rem);
        pg8::gemm_phase(lds, g, S, E);
        if (rem == 0) phase_vtab(p, wg, G); else if (shortwg && !first) phase_vtab(p, wg - rem, G - rem); }
    if constexpr (PH == 3) { phase_hgrn<0>(p, lds, wg, G); }
    if constexpr (PH == 4) { phase_attn(p, lds, wg, G); phase_hgrn<1>(p, lds, wg, G); }
    if constexpr (PH == 5) { pg8::StaticOrder S; S.init(NT, DM, G, wg); pg8::Gemm g{(const bf16_t*)(p.ws + WS_AB), (const bf16_t*)(p.ws + WS_WAT), NT, DM, DM}; EpiMerge2 E{p.ws}; pg8::gemm_phase(lds, g, S, E); }
    if constexpr (PH == 6) { pg8::StaticOrder S; S.init(NT, DM, G, wg); pg8::Gemm g{(const bf16_t*)(p.ws + WS_MERGED), (const bf16_t*)(p.ws + WS_WOT), NT, DM, DM}; EpiRes1 E{p.ws, p.x}; pg8::gemm_phase(lds, g, S, E); }
    if constexpr (PH == 7) { phase_ln1(p, wg, G); }
    if constexpr (PH == 8) { pg8::StaticOrder S; S.init(NT, DM, G, wg); pg8::Gemm g{(const bf16_t*)(p.ws + WS_H2), (const bf16_t*)(p.ws + WS_WQ8B), NT, DM, DM / 2}; EpiQP8 E{p.ws}; pg8::gemm_phase(lds, g, S, E);
        asm volatile("s_waitcnt vmcnt(0)" ::: "memory"); __syncthreads();
        pg8::Unit u; for (int i = 0; S.next(i, u); ++i) phase_route(p, lds, wg, G, u.pn, u.pm); }
    if constexpr (PH == 9) { }
    if constexpr (PH == 10) { phase_peer(p, lds, wg, G); }
}

struct KArgs { Params p; int ph_lo, ph_hi; };

__global__ void __launch_bounds__(NTHR, 2) k_fwd(KArgs a) {
    LAS unsigned char* lds = (LAS unsigned char*)smem_raw;
    const int wg = blockIdx.x, G = gridDim.x;
    volatile LAS unsigned* st = (volatile LAS unsigned*)(lds + LDS_BAR_OFF);
    XcdBarrier xb; xb.bar = (unsigned*)(a.p.ws + WS_BAR); xb.x = 0; xb.st = st;
    if (a.ph_hi - a.ph_lo > 1) {
        if (threadIdx.x == 0) { st[0] = 0; st[1] = 0; st[2] = 0; st[3] = 0; }
        __syncthreads();
        xb = xcd_barrier_post((unsigned*)(a.p.ws + WS_BAR), st);
    }
#ifndef DOUBLE_MASK
#define DOUBLE_MASK 0
#endif
#define OPAQUE_WS(Q) { unsigned long long u_ = (unsigned long long)(Q).ws; asm volatile("" : "+s"(u_)); (Q).ws = (unsigned char*)(__attribute__((address_space(1))) unsigned char*)u_; }
#define RUN_PHASE(PH) if (a.ph_lo <= PH && PH < a.ph_hi) { Params q = a.p; OPAQUE_WS(q); run_phase<PH>(q, lds, wg, G); \
        if ((DOUBLE_MASK >> PH) & 1) { xcd_barrier(xb); OPAQUE_WS(q); run_phase<PH>(q, lds, wg, G); } \
        if (PH + 1 < a.ph_hi) xcd_barrier(xb); }
    RUN_PHASE(0) RUN_PHASE(1) RUN_PHASE(2)
#if (DOUBLE_MASK & 0x18) == 0
    if (a.ph_lo <= 3 && 4 < a.ph_hi) {
        { Params q = a.p; OPAQUE_WS(q); run_phase<3>(q, lds, wg, G); }
        xcd_barrier_arrive(xb);
        { Params q = a.p; OPAQUE_WS(q); phase_attn(q, lds, wg, G); }
        xcd_barrier_wait(xb);
        { Params q = a.p; OPAQUE_WS(q); phase_hgrn<1>(q, lds, wg, G); }
        if (5 < a.ph_hi) xcd_barrier(xb);
    } else { RUN_PHASE(3) RUN_PHASE(4) }
#else
    RUN_PHASE(3) RUN_PHASE(4)
#endif
    RUN_PHASE(5) RUN_PHASE(6) RUN_PHASE(7) RUN_PHASE(8) RUN_PHASE(10)
#undef RUN_PHASE
}

#ifndef N_LAUNCH_MODE
#define N_LAUNCH_MODE 1
#endif

extern "C" void kernel_launch(void* const* d_in, const int* in_sizes, int n_in, void* d_out, int out_size, void* d_ws, size_t ws_size, hipStream_t stream) {
    static int grid = 0;
    if (grid == 0) {
        if (n_in != 18 || out_size != NT * DM || ws_size < WS_END) { fprintf(stderr, "kernel_launch: unexpected shapes (n_in %d out %d ws %zu need %zu)\n", n_in, out_size, ws_size, (size_t)WS_END); grid = -1; return; }
        int dev = 0, cus = 0;
        if (hipGetDevice(&dev) != hipSuccess || hipDeviceGetAttribute(&cus, hipDeviceAttributeMultiprocessorCount, dev) != hipSuccess) { grid = -1; return; }
        if (hipFuncSetAttribute((const void*)k_fwd, hipFuncAttributeMaxDynamicSharedMemorySize, LDS_BYTES) != hipSuccess) { fprintf(stderr, "kernel_launch: hipFuncSetAttribute failed\n"); grid = -1; return; }
        grid = cus;
    }
    if (grid < 0) return;
    (void)hipMemsetAsync((char*)d_ws + WS_BAR, 0, XCD_BAR_WORDS * 4, stream);
    KArgs a{};
    const float** pp = (const float**)&a.p;
    for (int i = 0; i < 18; ++i) pp[i] = (const float*)d_in[i];
    a.p.out = (float*)d_out; a.p.ws = (unsigned char*)d_ws;
#if N_LAUNCH_MODE == 1
    a.ph_lo = 0; a.ph_hi = N_PHASES;
    hipLaunchKernelGGL(k_fwd, dim3(grid), dim3(NTHR), LDS_BYTES, stream, a);
#else
    for (int ph = 0; ph < N_PHASES; ++ph) { a.ph_lo = ph; a.ph_hi = ph + 1; hipLaunchKernelGGL(k_fwd, dim3(grid), dim3(NTHR), LDS_BYTES, stream, a); }
#endif
}
```

```cpp
#include <hip/hip_runtime.h>
#include <cstdio>
#include <cstdint>

#define LAS __attribute__((address_space(3)))
typedef unsigned short bf16_t;
typedef short bf16x8 __attribute__((ext_vector_type(8)));
typedef float f32x4 __attribute__((ext_vector_type(4)));
typedef float f32x2 __attribute__((ext_vector_type(2)));
typedef float f32x16 __attribute__((ext_vector_type(16)));
typedef unsigned u32x4 __attribute__((ext_vector_type(4)));
typedef int i32x4 __attribute__((ext_vector_type(4)));
typedef unsigned u32x2 __attribute__((ext_vector_type(2)));

constexpr int NB = 2, SEQ = 4096, DM = 2048, NT = NB * SEQ, DIN = 11264;
constexpr int NH = 8, HD = 128, HW = 1024;
constexpr int NEXP = 16384, NKEYS = 128, TOPK = 16, PH = 8;
constexpr float ALPHA = 1.189207115002721f;
constexpr float LN_EPS = 1e-5f, RMS_EPS = 1e-6f;
constexpr float LOG2E = 1.4426950408889634f;
constexpr int NTHR = 512;

constexpr size_t MB = 1024 * 1024;
constexpr size_t WS_BAR   = 0;
constexpr size_t WS_MOD   = 64 * 1024;
constexpr size_t WS_LB    = WS_MOD + 128 * 1024;
constexpr size_t WS_STAT1 = WS_LB + 4096;
constexpr size_t WS_HGAM  = WS_STAT1 + 65536;
constexpr size_t WS_RIDX  = 1 * MB;
constexpr size_t WS_RGATE = WS_RIDX + 4 * MB;
constexpr size_t WS_HST   = WS_RGATE + 4 * MB;
constexpr size_t WS_WINT  = WS_HST + 16 * MB;
constexpr size_t WS_WAT   = WS_WINT + 44 * MB;
constexpr size_t WS_WBT   = WS_WAT + 4 * MB;
constexpr size_t WS_WOT   = WS_WBT + 4 * MB;
constexpr size_t WS_WQT   = WS_WOT + 8 * MB;
constexpr size_t WS_SKB   = WS_WQT + 8 * MB;
constexpr size_t WS_UQ    = WS_SKB + 1 * MB;
constexpr size_t WS_VQ    = WS_UQ + 32 * MB;
constexpr size_t WS_USC   = WS_VQ + 32 * MB;
constexpr size_t WS_VSC   = WS_USC + 64 * 1024;
constexpr size_t WS_SH    = WS_USC + 128 * 1024;
constexpr size_t WS_SW    = WS_SH + 64 * 1024;
constexpr size_t WS_SH2   = WS_SH + 32 * 1024;
constexpr size_t WS_SWQ   = WS_SH + 112 * 1024;
constexpr size_t WS_RUS   = WS_USC + 1 * MB;
constexpr size_t WS_WQ8   = WS_USC + 8 * MB;
constexpr size_t WS_WQ8B  = WS_WQ8 + 24 * MB;
constexpr size_t WS_VBF   = WS_UQ + 64 * MB;
constexpr size_t WS_HBF   = WS_VBF + 64 * MB;
constexpr size_t WS_AB    = WS_HBF;
constexpr size_t WS_PROJ  = WS_HBF + 32 * MB;
constexpr size_t WS_Q     = WS_PROJ;
constexpr size_t WS_K     = WS_Q + 16 * MB;
constexpr size_t WS_VT    = WS_K + 16 * MB;
constexpr size_t WS_HQ    = WS_VT + 16 * MB;
constexpr size_t WS_HF    = WS_HQ + 16 * MB;
constexpr size_t WS_HI    = WS_HF + 16 * MB;
constexpr size_t WS_HG    = WS_HI + 16 * MB;
constexpr size_t WS_GA    = WS_HG + 16 * MB;
constexpr size_t WS_GB    = WS_GA + 32 * MB;
constexpr size_t WS_END   = WS_GB + 32 * MB;
constexpr size_t WS_MERGED = WS_Q;
constexpr size_t WS_R1     = WS_VT;
constexpr size_t WS_H2     = WS_GA;
constexpr size_t WS_QP     = WS_GB;

struct Params {
    const float *x, *c, *w_ada, *b_ada, *w_in, *lb_logits, *hg_norm_g, *w_a, *w_b, *w_out, *ln1_g, *ln1_b, *peer_wq, *subkeys, *peer_u, *peer_v, *ln2_g, *ln2_b;
    float* out;
    unsigned char* ws;
};

__device__ __forceinline__ int opaque_tid() { int t = threadIdx.x; asm volatile("" : "+v"(t)); return t; }
typedef __bf16 bf16x2_t __attribute__((ext_vector_type(2)));
__device__ __forceinline__ unsigned pk2(float lo, float hi) { const bf16x2_t v = __builtin_convertvector((f32x2){lo, hi}, bf16x2_t); return __builtin_bit_cast(unsigned, v); }
__device__ __forceinline__ float bf_lo(unsigned u) { return __uint_as_float(u << 16); }
__device__ __forceinline__ float bf_hi(unsigned u) { return __uint_as_float(u & 0xffff0000u); }
__device__ __forceinline__ float bf2f(bf16_t b) { return __uint_as_float(((unsigned)b) << 16); }
__device__ __forceinline__ bf16_t f2bf(float f) { return (bf16_t)(pk2(f, 0.f) & 0xffffu); }
__device__ __forceinline__ float fast_exp2(float x) { return __builtin_amdgcn_exp2f(x); }
__device__ __forceinline__ float fast_log2(float x) { return __builtin_amdgcn_logf(x); }
__device__ __forceinline__ float fast_rcp(float x) { return __builtin_amdgcn_rcpf(x); }
__device__ __forceinline__ float sigmoidf_(float v) { return fast_rcp(1.f + fast_exp2(-v * LOG2E)); }
__device__ __forceinline__ float siluf_(float v) { return v * sigmoidf_(v); }
__device__ __forceinline__ float wave_sum(float v) {
    v += __int_as_float(__builtin_amdgcn_update_dpp(0, __float_as_int(v), 0x111, 0xf, 0xf, false));
    v += __int_as_float(__builtin_amdgcn_update_dpp(0, __float_as_int(v), 0x112, 0xf, 0xf, false));
    v += __int_as_float(__builtin_amdgcn_update_dpp(0, __float_as_int(v), 0x114, 0xf, 0xf, false));
    v += __int_as_float(__builtin_amdgcn_update_dpp(0, __float_as_int(v), 0x118, 0xf, 0xf, false));
    const float t0 = __int_as_float(__builtin_amdgcn_readlane(__float_as_int(v), 15)), t1 = __int_as_float(__builtin_amdgcn_readlane(__float_as_int(v), 31)),
                t2 = __int_as_float(__builtin_amdgcn_readlane(__float_as_int(v), 47)), t3 = __int_as_float(__builtin_amdgcn_readlane(__float_as_int(v), 63));
    return (t0 + t1) + (t2 + t3);
}
__device__ __forceinline__ float wave_max_nonneg(float v) {
    v = fmaxf(v, __int_as_float(__builtin_amdgcn_update_dpp(0, __float_as_int(v), 0x111, 0xf, 0xf, false)));
    v = fmaxf(v, __int_as_float(__builtin_amdgcn_update_dpp(0, __float_as_int(v), 0x112, 0xf, 0xf, false)));
    v = fmaxf(v, __int_as_float(__builtin_amdgcn_update_dpp(0, __float_as_int(v), 0x114, 0xf, 0xf, false)));
    v = fmaxf(v, __int_as_float(__builtin_amdgcn_update_dpp(0, __float_as_int(v), 0x118, 0xf, 0xf, false)));
    const float t0 = __int_as_float(__builtin_amdgcn_readlane(__float_as_int(v), 15)), t1 = __int_as_float(__builtin_amdgcn_readlane(__float_as_int(v), 31)),
                t2 = __int_as_float(__builtin_amdgcn_readlane(__float_as_int(v), 47)), t3 = __int_as_float(__builtin_amdgcn_readlane(__float_as_int(v), 63));
    return fmaxf(fmaxf(t0, t1), fmaxf(t2, t3));
}

#define XB_TMO      128
#define XB_XCNT(j)  (256  + 64 * (j))
#define XB_XSUB(j)  (1280 + 64 * (j))
#define XB_XGEN(j)  (2304 + 64 * (j))
#define XB_TOP      3328
#define XB_TOPGEN   3392
#define XCD_BAR_WORDS 3456
#define XB_SPIN_CAP (1u << 22)
__device__ __forceinline__ unsigned xb_ld(unsigned* p)              { return __hip_atomic_load(p, __ATOMIC_RELAXED, __HIP_MEMORY_SCOPE_AGENT); }
__device__ __forceinline__ unsigned xb_add(unsigned* p, unsigned v) { return __hip_atomic_fetch_add(p, v, __ATOMIC_RELAXED, __HIP_MEMORY_SCOPE_AGENT); }
__device__ __forceinline__ unsigned xb_xcc_id() { return (unsigned)__builtin_amdgcn_s_getreg((3 << 11) | 20) & 0xFu; }
#define XB_SPIN(cond, bar) do { unsigned _sp = 0; while (cond) { __builtin_amdgcn_s_sleep(1); \
    if ((++_sp & 255u) == 0u) { if (xb_ld(&(bar)[XB_TMO])) break; if (_sp > XB_SPIN_CAP) { atomicAdd(&(bar)[XB_TMO], 1u); break; } } } } while (0)
struct XcdBarrier { unsigned* bar; unsigned x; volatile LAS unsigned* st; };
__device__ __forceinline__ XcdBarrier xcd_barrier_post(unsigned* bar, volatile LAS unsigned* st) {
    XcdBarrier b; b.bar = bar; b.x = xb_xcc_id(); b.st = st;
    if (threadIdx.x == 0) (void)xb_add(&bar[XB_XCNT(b.x)], 1u);
    return b;
}
__device__ __forceinline__ void xcd_barrier_complete(unsigned* bar, unsigned x, unsigned& nloc, unsigned& nx) {
    const unsigned G = gridDim.x * gridDim.y * gridDim.z;
    unsigned sum, cnt, mine, sp = 0u;
    for (;;) {
        sum = 0u; cnt = 0u; mine = 0u;
#pragma unroll
        for (unsigned j = 0; j < 16; ++j) { const unsigned c = xb_ld(&bar[XB_XCNT(j)]); sum += c; cnt += (c > 0u) ? 1u : 0u; mine = (j == x) ? c : mine; }
        if (sum == G) break;
        __builtin_amdgcn_s_sleep(1);
        if ((++sp & 255u) == 0u) { if (xb_ld(&bar[XB_TMO])) break; if (sp > XB_SPIN_CAP) { atomicAdd(&bar[XB_TMO], 1u); break; } }
    }
    nloc = mine > 0u ? mine : 1u; nx = cnt > 0u ? cnt : 1u;
}
__device__ __forceinline__ void xcd_barrier(const XcdBarrier& b) {
    asm volatile("s_waitcnt vmcnt(0)" ::: "memory");
    __syncthreads();
    if (threadIdx.x == 0) {
        unsigned* bar = b.bar;
        __builtin_amdgcn_s_waitcnt(0);
        unsigned nloc = b.st[0], nx = b.st[1];
        if (nloc == 0u) { xcd_barrier_complete(bar, b.x, nloc, nx); b.st[0] = nloc; b.st[1] = nx; }
        const unsigned old = xb_add(&bar[XB_XSUB(b.x)], 1u);
        const unsigned gen = old / nloc;
        if (old + 1u == (gen + 1u) * nloc) {
            __builtin_amdgcn_fence(__ATOMIC_RELEASE, "agent");
            asm volatile("s_waitcnt vmcnt(0)" ::: "memory");
            const unsigned og = xb_add(&bar[XB_TOP], 1u);
            const unsigned tg = og / nx;
            if (og + 1u == (tg + 1u) * nx) xb_add(&bar[XB_TOPGEN], 1u);
            else XB_SPIN(xb_ld(&bar[XB_TOPGEN]) == tg, bar);
            __builtin_amdgcn_fence(__ATOMIC_ACQUIRE, "agent");
            xb_add(&bar[XB_XGEN(b.x)], 1u);
            asm volatile("s_waitcnt vmcnt(0)" ::: "memory");
        } else {
            XB_SPIN((int)(xb_ld(&bar[XB_XGEN(b.x)]) - gen) <= 0, bar);
            __builtin_amdgcn_fence(__ATOMIC_ACQUIRE, "agent");
            asm volatile("s_waitcnt vmcnt(0)" ::: "memory");
        }
    }
    __syncthreads();
}

__device__ __forceinline__ void xcd_barrier_arrive(const XcdBarrier& b) {
    asm volatile("s_waitcnt vmcnt(0)" ::: "memory");
    __syncthreads();
    if (threadIdx.x == 0) {
        unsigned* bar = b.bar;
        __builtin_amdgcn_s_waitcnt(0);
        unsigned nloc = b.st[0], nx = b.st[1];
        if (nloc == 0u) { xcd_barrier_complete(bar, b.x, nloc, nx); b.st[0] = nloc; b.st[1] = nx; }
        const unsigned old = xb_add(&bar[XB_XSUB(b.x)], 1u);
        const unsigned gen = old / nloc;
        const unsigned leader = (old + 1u == (gen + 1u) * nloc) ? 1u : 0u;
        if (leader) {
            __builtin_amdgcn_fence(__ATOMIC_RELEASE, "agent");
            asm volatile("s_waitcnt vmcnt(0)" ::: "memory");
            const unsigned og = xb_add(&bar[XB_TOP], 1u);
            const unsigned tg = og / nx;
            if (og + 1u == (tg + 1u) * nx) xb_add(&bar[XB_TOPGEN], 1u);
        }
        b.st[2] = gen; b.st[3] = leader;
    }
}
__device__ __forceinline__ void xcd_barrier_wait(const XcdBarrier& b) {
    asm volatile("s_waitcnt vmcnt(0)" ::: "memory");
    __syncthreads();
    if (threadIdx.x == 0) {
        unsigned* bar = b.bar;
        const unsigned gen = b.st[2], leader = b.st[3];
        XB_SPIN((int)(xb_ld(&bar[XB_TOPGEN]) - gen) <= 0, bar);
        __builtin_amdgcn_fence(__ATOMIC_ACQUIRE, "agent");
        if (leader) xb_add(&bar[XB_XGEN(b.x)], 1u);
        asm volatile("s_waitcnt vmcnt(0)" ::: "memory");
    }
    __syncthreads();
}

__device__ __forceinline__ void phase_ada(const Params& p, LAS unsigned char* lds, int wg, int G) {
    LAS float* cond = (LAS float*)lds;
    LAS float* red = cond + 4096;
    const int tid = opaque_tid(), w = tid >> 6, lane = tid & 63;
    float* mod = (float*)(p.ws + WS_MOD);
    for (int i = tid; i < 2 * DM; i += NTHR) { const float v = p.c[i]; cond[i] = v / (1.f + __expf(-v)); }
    __syncthreads();
    const int r5 = lane / 12, c4 = lane % 12; const bool act = lane < 60;
    for (int item = wg; item < 256; item += G) {
        const int n0 = item * 48;
        f32x4 a0 = {0.f, 0.f, 0.f, 0.f}, a1 = {0.f, 0.f, 0.f, 0.f};
        if (act) {
#pragma unroll 4
            for (int k = w * 5 + r5; k < DM; k += 40) {
                const f32x4 wv = *(const f32x4*)(p.w_ada + (size_t)k * (6 * DM) + n0 + c4 * 4);
                const float c0 = cond[k], c1 = cond[DM + k];
                a0 += c0 * wv; a1 += c1 * wv;
            }
            LAS float* r = red + ((w * 5 + r5) * 12 + c4) * 8;
            *(LAS f32x4*)r = a0; *(LAS f32x4*)(r + 4) = a1;
        }
        __syncthreads();
        if (tid < 96) {
            const int b = tid / 48, n = tid % 48, cc = n >> 2, j = n & 3;
            float s = 0.f;
            for (int g = 0; g < 40; ++g) s += red[(g * 12 + cc) * 8 + b * 4 + j];
            mod[b * (6 * DM) + n0 + n] = s + p.b_ada[n0 + n];
        }
        __syncthreads();
    }
}

__device__ __forceinline__ void transpose_tile(const float* W, int K, int N, bf16_t* WT, int k0, int n0, LAS float* scr, int tid, int ldk = 0, int koff = 0) {
    if (ldk == 0) ldk = K;
#pragma unroll
    for (int i = 0; i < 2; ++i) {
        const int idx = tid + i * NTHR, r = idx >> 4, cq = idx & 15;
        const f32x4 v = *(const f32x4*)(W + (size_t)(k0 + r) * N + n0 + cq * 4);
        LAS float* d = scr + r * 65 + cq * 4;
        d[0] = v[0]; d[1] = v[1]; d[2] = v[2]; d[3] = v[3];
    }
    __syncthreads();
    {
        const int n = tid >> 3, kc = tid & 7;
        const LAS float* s = scr + (kc * 8) * 65 + n;
        u32x4 o; o.x = pk2(s[0], s[65]); o.y = pk2(s[2 * 65], s[3 * 65]); o.z = pk2(s[4 * 65], s[5 * 65]); o.w = pk2(s[6 * 65], s[7 * 65]);
        *(u32x4*)(WT + (size_t)(n0 + n) * ldk + koff + k0 + kc * 8) = o;
    }
    __syncthreads();
}
__device__ __forceinline__ void convert_chunk(const float* src, bf16_t* dst, size_t e0, int tid) {
    const f32x4 a = *(const f32x4*)(src + e0 + (size_t)tid * 8), b = *(const f32x4*)(src + e0 + (size_t)tid * 8 + 4);
    u32x4 o; o.x = pk2(a[0], a[1]); o.y = pk2(a[2], a[3]); o.z = pk2(b[0], b[1]); o.w = pk2(b[2], b[3]);
    *(u32x4*)(dst + e0 + (size_t)tid * 8) = o;
}
template <int OFFS>
__device__ __forceinline__ void quantize_row(const float* src, unsigned char* dst, float* scales, int row, int lane) {
    const float* s = src + (size_t)row * DM;
    f32x4 v[8]; float am = 0.f;
#pragma unroll
    for (int j = 0; j < 2; ++j)
#pragma unroll
        for (int q = 0; q < 4; ++q) { v[4 * j + q] = *(const f32x4*)(s + 1024 * j + 16 * lane + 4 * q);
            am = fmaxf(am, fmaxf(fmaxf(fabsf(v[4 * j + q][0]), fabsf(v[4 * j + q][1])), fmaxf(fabsf(v[4 * j + q][2]), fabsf(v[4 * j + q][3])))); }
    am = wave_max_nonneg(am);
    const float sc = am > 0.f ? am * (1.f / 127.f) : 1.f, inv = am > 0.f ? 127.f / am : 0.f;
    if (lane == 0) scales[row] = sc;
#pragma unroll
    for (int j = 0; j < 2; ++j) {
        unsigned wds[4];
#pragma unroll
        for (int q = 0; q < 4; ++q) {
            unsigned wd = 0;
#pragma unroll
            for (int k = 0; k < 4; ++k) { int qi = (int)rintf(v[4 * j + q][k] * inv); qi = qi < -127 ? -127 : (qi > 127 ? 127 : qi); wd |= ((unsigned)(qi + OFFS) & 0xffu) << (8 * k); }
            wds[q] = wd;
        }
        *(u32x4*)(dst + (size_t)row * DM + 1024 * j + 16 * lane) = (u32x4){wds[0], wds[1], wds[2], wds[3]};
    }
}
#ifndef V_FP6
#define V_FP6 1
#endif
#ifndef U_FP6
#define U_FP6 0
#endif
#ifndef V_FP4
#define V_FP4 1
#endif
constexpr int VROW = V_FP4 ? 1024 : (V_FP6 ? 1536 : 2048);
constexpr int UROW = U_FP6 ? 1536 : 2048;
typedef float f32x16v __attribute__((ext_vector_type(16)));
typedef float f32x32v __attribute__((ext_vector_type(32)));
typedef unsigned u32x6v __attribute__((ext_vector_type(6)));
typedef _Float16 f16x2v __attribute__((ext_vector_type(2)));
typedef _Float16 f16x8v __attribute__((ext_vector_type(8)));
typedef _Float16 f16x32v __attribute__((ext_vector_type(32)));
__device__ __forceinline__ u32x6v pack_fp6_2x16(const f32x16v& a, const f32x16v& b) {
    u32x6v r;
    asm volatile("v_cvt_scalef32_2xpk16_fp6_f32 %0, %1, %2, 1.0" : "=&v"(r) : "v"(a), "v"(b));
    return r;
}
__device__ __forceinline__ void utab_load(const Params& p, int row, int lane, f32x4 (&v)[8]) {
    const float* s = p.peer_u + (size_t)row * DM;
#pragma unroll
    for (int j = 0; j < 2; ++j)
#pragma unroll
        for (int q = 0; q < 4; ++q) v[4 * j + q] = *(const f32x4*)(s + 1024 * j + 16 * lane + 4 * q);
}
__device__ __forceinline__ void utab_quant_store(const Params& p, int row, int lane, const f32x4 (&v)[8]) {
    float am = 0.f;
#pragma unroll
    for (int i = 0; i < 8; ++i) am = fmaxf(am, fmaxf(fmaxf(fabsf(v[i][0]), fabsf(v[i][1])), fmaxf(fabsf(v[i][2]), fabsf(v[i][3]))));
    am = wave_max_nonneg(am);
#if U_FP6
    const float sc = am > 0.f ? am * (1.f / 7.5f) : 1.f, inv = am > 0.f ? 7.5f / am : 0.f;
    if (lane == 0) ((float*)(p.ws + WS_USC))[row] = sc;
    f32x16v a, b;
#pragma unroll
    for (int i = 0; i < 8; ++i) { a[2 * i] = v[i][0] * inv; b[2 * i] = v[i][1] * inv; a[2 * i + 1] = v[i][2] * inv; b[2 * i + 1] = v[i][3] * inv; }
    const u32x6v pk = pack_fp6_2x16(a, b);
    unsigned char* d = p.ws + WS_UQ + (size_t)row * UROW;
    *(u32x4*)(d + 16 * lane) = (u32x4){pk[0], pk[1], pk[2], pk[3]};
    *(u32x2*)(d + 1024 + 8 * lane) = (u32x2){pk[4], pk[5]};
#else
    const float sc = am > 0.f ? am * (1.f / 127.f) : 1.f, inv = am > 0.f ? 127.f / am : 0.f;
    if (lane == 0) ((float*)(p.ws + WS_USC))[row] = sc;
#pragma unroll
    for (int j = 0; j < 2; ++j) {
        unsigned wds[4];
#pragma unroll
        for (int q = 0; q < 4; ++q) { unsigned wd = 0;
#pragma unroll
            for (int k = 0; k < 4; ++k) { int qi = (int)rintf(v[4 * j + q][k] * inv); qi = qi < -127 ? -127 : (qi > 127 ? 127 : qi); wd |= ((unsigned)qi & 0xffu) << (8 * k); }
            wds[q] = wd; }
        *(u32x4*)(p.ws + WS_UQ + (size_t)row * DM + 1024 * j + 16 * lane) = (u32x4){wds[0], wds[1], wds[2], wds[3]};
    }
#endif
}
__device__ __forceinline__ void quantize_row_fp6(const float* src, unsigned char* dst, float* scales, int row, int lane) {
    const float* s = src + (size_t)row * DM;
    f32x4 v[8]; float am = 0.f;
#pragma unroll
    for (int j = 0; j < 2; ++j)
#pragma unroll
        for (int q = 0; q < 4; ++q) { v[4 * j + q] = *(const f32x4*)(s + 1024 * j + 16 * lane + 4 * q);
            am = fmaxf(am, fmaxf(fmaxf(fabsf(v[4 * j + q][0]), fabsf(v[4 * j + q][1])), fmaxf(fabsf(v[4 * j + q][2]), fabsf(v[4 * j + q][3])))); }
    am = wave_max_nonneg(am);
    const float sc = am > 0.f ? am * (1.f / 7.5f) : 1.f, inv = am > 0.f ? 7.5f / am : 0.f;
    if (lane == 0) scales[row] = sc;
    f32x16v a, b;
#pragma unroll
    for (int i = 0; i < 8; ++i) { a[2 * i] = v[i][0] * inv; b[2 * i] = v[i][1] * inv; a[2 * i + 1] = v[i][2] * inv; b[2 * i + 1] = v[i][3] * inv; }
    const u32x6v pk = pack_fp6_2x16(a, b);
    unsigned char* d = dst + (size_t)row * VROW;
    *(u32x4*)(d + 16 * lane) = (u32x4){pk[0], pk[1], pk[2], pk[3]};
    *(u32x2*)(d + 1024 + 8 * lane) = (u32x2){pk[4], pk[5]};
}
__device__ __forceinline__ void quantize_row_fp4(const float* src, unsigned char* dst, float* scales, int row, int lane) {
    const float* s = src + (size_t)row * DM;
    f32x4 v[8]; float am = 0.f;
#pragma unroll
    for (int j = 0; j < 2; ++j)
#pragma unroll
        for (int q = 0; q < 4; ++q) { v[4 * j + q] = *(const f32x4*)(s + 1024 * j + 16 * lane + 4 * q);
            am = fmaxf(am, fmaxf(fmaxf(fabsf(v[4 * j + q][0]), fabsf(v[4 * j + q][1])), fmaxf(fabsf(v[4 * j + q][2]), fabsf(v[4 * j + q][3])))); }
    am = wave_max_nonneg(am);
    const float sc = am > 0.f ? am * (1.f / 6.f) : 1.f, inv = am > 0.f ? 6.f / am : 0.f;
    if (lane == 0) scales[row] = sc;
    unsigned wd[4];
#pragma unroll
    for (int q = 0; q < 4; ++q) {
        unsigned w = 0;
        w = __builtin_amdgcn_cvt_scalef32_pk_fp4_f32(w, v[2 * q][0] * inv, v[2 * q][1] * inv, 1.0f, 0);
        w = __builtin_amdgcn_cvt_scalef32_pk_fp4_f32(w, v[2 * q][2] * inv, v[2 * q][3] * inv, 1.0f, 1);
        w = __builtin_amdgcn_cvt_scalef32_pk_fp4_f32(w, v[2 * q + 1][0] * inv, v[2 * q + 1][1] * inv, 1.0f, 2);
        w = __builtin_amdgcn_cvt_scalef32_pk_fp4_f32(w, v[2 * q + 1][2] * inv, v[2 * q + 1][3] * inv, 1.0f, 3);
        wd[q] = w;
    }
    *(u32x4*)(dst + (size_t)row * VROW + 16 * lane) = (u32x4){wd[0], wd[1], wd[2], wd[3]};
}
__device__ __forceinline__ void quantize_row_fp8(const float* src, unsigned char* dst, float* scales, int row, int lane) {
    const float* s = src + (size_t)row * DM;
    f32x4 v[8]; float am = 0.f;
#pragma unroll
    for (int j = 0; j < 2; ++j)
#pragma unroll
        for (int q = 0; q < 4; ++q) { v[4 * j + q] = *(const f32x4*)(s + 1024 * j + 16 * lane + 4 * q);
            am = fmaxf(am, fmaxf(fmaxf(fabsf(v[4 * j + q][0]), fabsf(v[4 * j + q][1])), fmaxf(fabsf(v[4 * j + q][2]), fabsf(v[4 * j + q][3])))); }
    am = wave_max_nonneg(am);
    const float sc = am > 0.f ? am * (1.f / 448.f) : 1.f, inv = am > 0.f ? 448.f / am : 0.f;
    if (lane == 0) scales[row] = sc;
#pragma unroll
    for (int j = 0; j < 2; ++j) {
        unsigned wds[4];
#pragma unroll
        for (int q = 0; q < 4; ++q) {
            int wd = __builtin_amdgcn_cvt_pk_fp8_f32(v[4 * j + q][0] * inv, v[4 * j + q][1] * inv, 0, false);
            wd = __builtin_amdgcn_cvt_pk_fp8_f32(v[4 * j + q][2] * inv, v[4 * j + q][3] * inv, wd, true);
            wds[q] = (unsigned)wd;
        }
        *(u32x4*)(dst + (size_t)row * DM + 1024 * j + 16 * lane) = (u32x4){wds[0], wds[1], wds[2], wds[3]};
    }
}
constexpr int TRS = 260;
__device__ __forceinline__ void tr_loop(const float* W, bf16_t* WT, int N, int ldk, int koff, int ntiles, int first, int G, LAS float* scr, int tid) {
    const int nb = N / 256;
    const int r0 = tid >> 6, cq = tid & 63;
    const int n = tid >> 1, kc = tid & 1;
    for (int r = first; r < ntiles; r += G) {
        const int k0 = (r / nb) * 64, n0 = (r % nb) * 256;
        f32x4 v[8];
#pragma unroll
        for (int i = 0; i < 8; ++i) v[i] = *(const f32x4*)(W + (size_t)(k0 + r0 + 8 * i) * N + n0 + cq * 4);
#pragma unroll
        for (int i = 0; i < 8; ++i) *(LAS f32x4*)(scr + (r0 + 8 * i) * TRS + cq * 4) = v[i];
        __syncthreads();
        const LAS float* s = scr + (kc * 32) * TRS + n;
        bf16_t* dst = WT + (size_t)(n0 + n) * ldk + koff + k0 + kc * 32;
#pragma unroll
        for (int q = 0; q < 4; ++q) {
            u32x4 o; o.x = pk2(s[(8 * q) * TRS], s[(8 * q + 1) * TRS]); o.y = pk2(s[(8 * q + 2) * TRS], s[(8 * q + 3) * TRS]);
            o.z = pk2(s[(8 * q + 4) * TRS], s[(8 * q + 5) * TRS]); o.w = pk2(s[(8 * q + 6) * TRS], s[(8 * q + 7) * TRS]);
            *(u32x4*)(dst + 8 * q) = o;
        }
        __syncthreads();
    }
}
__device__ __forceinline__ void colblock_quant(const float* W, int N, unsigned char* WQ, float* scales, int n0, LAS float* scr, int tid) {
    const int r0 = tid >> 4, cq = tid & 15;
    LAS float* red = scr + 64 * 65;
    f32x4 am = {0.f, 0.f, 0.f, 0.f};
#pragma unroll 8
    for (int i = 0; i < DM / 32; ++i) {
        const f32x4 v = *(const f32x4*)(W + (size_t)(r0 + 32 * i) * N + n0 + cq * 4);
        am[0] = fmaxf(am[0], fabsf(v[0])); am[1] = fmaxf(am[1], fabsf(v[1])); am[2] = fmaxf(am[2], fabsf(v[2])); am[3] = fmaxf(am[3], fabsf(v[3]));
    }
    *(LAS f32x4*)(red + r0 * 64 + cq * 4) = am;
    __syncthreads();
    if (tid < 64) { float m = 0.f; for (int g = 0; g < 32; ++g) m = fmaxf(m, red[g * 64 + tid]); scales[n0 + tid] = m > 0.f ? m * (1.f / 127.f) : 1.f; red[32 * 64 + tid] = m > 0.f ? 127.f / m : 0.f; }
    __syncthreads();
    const f32x4 inv = *(const LAS f32x4*)(red + 32 * 64 + cq * 4);
    const int n = tid >> 3, kc = tid & 7;
    f32x4 v[2];
#pragma unroll
    for (int i = 0; i < 2; ++i) v[i] = *(const f32x4*)(W + (size_t)(r0 + 32 * i) * N + n0 + cq * 4);
    for (int kt = 0; kt < DM / 64; ++kt) {
#pragma unroll
        for (int i = 0; i < 2; ++i) { LAS float* dd = scr + (r0 + 32 * i) * 65 + cq * 4; dd[0] = rintf(v[i][0] * inv[0]); dd[1] = rintf(v[i][1] * inv[1]); dd[2] = rintf(v[i][2] * inv[2]); dd[3] = rintf(v[i][3] * inv[3]); }
        __syncthreads();
        if (kt + 1 < DM / 64) {
#pragma unroll
            for (int i = 0; i < 2; ++i) v[i] = *(const f32x4*)(W + (size_t)((kt + 1) * 64 + r0 + 32 * i) * N + n0 + cq * 4);
        }
        { const LAS float* s = scr + (kc * 8) * 65 + n;
          unsigned lo = 0, hi = 0;
#pragma unroll
          for (int e = 0; e < 4; ++e) { lo |= ((unsigned)(int)s[e * 65] & 0xffu) << (8 * e); hi |= ((unsigned)(int)s[(4 + e) * 65] & 0xffu) << (8 * e); }
          *(u32x2*)(WQ + (size_t)(n0 + n) * DM + kt * 64 + kc * 8) = (u32x2){lo, hi}; }
        __syncthreads();
    }
}
__device__ __forceinline__ void phase_conv(const Params& p, LAS unsigned char* lds, int wg, int G) {
    LAS float* scr = (LAS float*)lds;
    const int tid = opaque_tid();
    {
        constexpr int T_IN = (DM / 64) * (DIN / 256), T_AB = (HW / 64) * (DM / 256), T_SQ = (DM / 64) * (DM / 256);
        int base = 0;
        tr_loop(p.w_in, (bf16_t*)(p.ws + WS_WINT), DIN, DM, 0, T_IN, (((wg - base) % G) + G) % G, G, scr, tid); base += T_IN;
        tr_loop(p.w_a, (bf16_t*)(p.ws + WS_WAT), DM, 2 * HW, 0, T_AB, (((wg - base) % G) + G) % G, G, scr, tid); base += T_AB;
        tr_loop(p.w_b, (bf16_t*)(p.ws + WS_WAT), DM, 2 * HW, HW, T_AB, (((wg - base) % G) + G) % G, G, scr, tid); base += T_AB;
        tr_loop(p.w_out, (bf16_t*)(p.ws + WS_WOT), DM, DM, 0, T_SQ, (((wg - base) % G) + G) % G, G, scr, tid); base += T_SQ;
        tr_loop(p.peer_wq, (bf16_t*)(p.ws + WS_WQT), DM, DM, 0, T_SQ, (((wg - base) % G) + G) % G, G, scr, tid);
    }
    constexpr int I_SK = PH * 2 * NKEYS * 128 / 4096;
    constexpr int NITEMS = I_SK + 1;
    for (int it = wg; it < NITEMS; it += G) {
        int r = it;
        if (r < I_SK) { convert_chunk(p.subkeys, (bf16_t*)(p.ws + WS_SKB), (size_t)r * 4096, tid); continue; } r -= I_SK;
        float* lb = (float*)(p.ws + WS_LB);
        for (int j = tid; j < HW; j += NTHR) { const float l0 = p.lb_logits[j], l1 = p.lb_logits[HW + j]; lb[j] = 1.f / (1.f + __expf(l1 - l0)); }
    }
}

__device__ __forceinline__ void phase_vtab(const Params& p, int sub, int nsub) {
    const int tid = opaque_tid();
    for (int r = sub; r < NEXP / 8; r += nsub) {
#if V_FP4
        quantize_row_fp4(p.peer_v, p.ws + WS_VQ, (float*)(p.ws + WS_VSC), r * 8 + (tid >> 6), tid & 63);
#elif V_FP6
        quantize_row_fp6(p.peer_v, p.ws + WS_VQ, (float*)(p.ws + WS_VSC), r * 8 + (tid >> 6), tid & 63);
#else
        quantize_row_fp8(p.peer_v, p.ws + WS_VQ, (float*)(p.ws + WS_VSC), r * 8 + (tid >> 6), tid & 63);
#endif
    }
}

__device__ __forceinline__ void quant_rows_bf16(const bf16_t* wt, unsigned char* wq, float* sws, int nrows, int wg, int G, int w, int lane) {
    for (int row = wg * 8 + w; row < nrows; row += G * 8) {
        float v[32]; float am = 0.f;
#pragma unroll
        for (int j = 0; j < 2; ++j)
#pragma unroll
            for (int q = 0; q < 2; ++q) {
                const u32x4 r = *(const u32x4*)(wt + (size_t)row * DM + 1024 * j + 16 * lane + 8 * q);
                float* vp = v + 16 * j + 8 * q;
                vp[0] = bf_lo(r.x); vp[1] = bf_hi(r.x); vp[2] = bf_lo(r.y); vp[3] = bf_hi(r.y); vp[4] = bf_lo(r.z); vp[5] = bf_hi(r.z); vp[6] = bf_lo(r.w); vp[7] = bf_hi(r.w);
            }
#pragma unroll
        for (int i = 0; i < 32; ++i) am = fmaxf(am, fabsf(v[i]));
        am = wave_max_nonneg(am);
        const float sc_ = am > 0.f ? am * (1.f / 127.f) : 1.f, inv = am > 0.f ? 127.f / am : 0.f;
        if (lane == 0) sws[row] = sc_;
#pragma unroll
        for (int j = 0; j < 2; ++j) {
            unsigned wd[4];
#pragma unroll
            for (int q = 0; q < 4; ++q) { unsigned x4 = 0;
#pragma unroll
                for (int e = 0; e < 4; ++e) { const int qi = (int)rintf(v[16 * j + 4 * q + e] * inv); x4 |= ((unsigned)qi & 0xffu) << (8 * e); }
                wd[q] = x4; }
            *(u32x4*)(wq + (size_t)row * DM + 1024 * j + 16 * lane) = (u32x4){wd[0], wd[1], wd[2], wd[3]};
        }
    }
}
__device__ __forceinline__ void phase_hmod(const Params& p, int wg, int G) {
    const int tid = opaque_tid(), w = tid >> 6, lane = tid & 63;
    const float* mod = (const float*)(p.ws + WS_MOD);
    unsigned char* hq = p.ws + WS_HBF; float* shs = (float*)(p.ws + WS_SH);
#pragma unroll 2
    for (int row = wg * 8 + w; row < NT; row += G * 8) {
        const int b = row / SEQ;
        f32x4 h[8]; float am = 0.f;
#pragma unroll
        for (int j = 0; j < 2; ++j)
#pragma unroll
            for (int q = 0; q < 4; ++q) {
                const int c = 1024 * j + 16 * lane + 4 * q;
                const f32x4 xv = *(const f32x4*)(p.x + (size_t)row * DM + c), sh = *(const f32x4*)(mod + b * 6 * DM + c), sc = *(const f32x4*)(mod + b * 6 * DM + DM + c);
                h[4 * j + q] = xv * (1.f + sc) + sh;
                am = fmaxf(am, fmaxf(fmaxf(fabsf(h[4 * j + q][0]), fabsf(h[4 * j + q][1])), fmaxf(fabsf(h[4 * j + q][2]), fabsf(h[4 * j + q][3]))));
            }
        am = wave_max_nonneg(am);
        const float sc_ = am > 0.f ? am * (1.f / 127.f) : 1.f, inv = am > 0.f ? 127.f / am : 0.f;
        if (lane == 0) shs[row] = sc_;
#pragma unroll
        for (int j = 0; j < 2; ++j) {
            unsigned wd[4];
#pragma unroll
            for (int q = 0; q < 4; ++q) { unsigned x4 = 0;
#pragma unroll
                for (int e = 0; e < 4; ++e) { const int qi = (int)rintf(h[4 * j + q][e] * inv); x4 |= ((unsigned)qi & 0xffu) << (8 * e); }
                wd[q] = x4; }
            *(u32x4*)(hq + (size_t)row * DM + 1024 * j + 16 * lane) = (u32x4){wd[0], wd[1], wd[2], wd[3]};
        }
    }

    quant_rows_bf16((const bf16_t*)(p.ws + WS_WINT), p.ws + WS_WQ8, (float*)(p.ws + WS_SW), DIN, wg, G, w, lane);
    quant_rows_bf16((const bf16_t*)(p.ws + WS_WQT), p.ws + WS_WQ8B, (float*)(p.ws + WS_SWQ), DM, wg, G, w, lane);
}
namespace pg8 {
constexpr int BM = 256, BK = 64, HALF = 128, HTB = HALF * BK * 2, STAGE_BYTES = 8 * HTB, NXCD = 8, WGM = 8;
__host__ __device__ __forceinline__ int lds_byte(int r, int c) { const int st = (r >> 4) * 2 + (c >> 5), rr = r & 15, cc = c & 31, ob = rr * 64 + cc * 2; return st * 1024 + (ob ^ (((ob >> 9) & 1) << 5)); }
__host__ __device__ __forceinline__ void stage_rc(int b, int& R, int& C) { const int st = b / 1024, sb = b % 1024, swz = sb ^ (((sb >> 9) & 1) << 5); R = (st >> 1) * 16 + swz / 64; C = (st & 1) * 32 + (swz % 64) / 2; }
__host__ __device__ __forceinline__ int perm32(int rho) { const int n = rho >> 4, i = rho & 15; return 8 * (i >> 2) + 4 * n + (i & 3); }
struct Unit { int pm, pn; };
struct Gemm { const bf16_t* A; const bf16_t* Bt; int M, N, K; };
struct StaticOrder {
    int nM, nN, nwg, G, c;
    __host__ __device__ void init(int M, int N, int G_, int c_) { nM = M / BM; nN = N / BM; nwg = nM * nN; G = G_; c = c_; }
    __host__ __device__ bool next(int i, Unit& u) const {
        const long L = (long)i * G + c; if (L >= nwg) return false;
        int wgid = (int)L; { const int q = nwg / NXCD, r = nwg % NXCD, xcd = wgid % NXCD, off = wgid / NXCD; wgid = (xcd < r ? xcd * (q + 1) : r * (q + 1) + (xcd - r) * q) + off; }
        const int nig = WGM * nN, gid = wgid / nig, fm = gid * WGM, gsz = (nM - fm) < WGM ? (nM - fm) : WGM;
        u.pm = fm + ((wgid % nig) % gsz); u.pn = (wgid % nig) / gsz; return true;
    }
};
template <class Epi, class Sched>
__device__ __forceinline__ void gemm_phase(LAS unsigned char* lds, const Gemm g, const Sched& S, const Epi& E) {
    const int tid = opaque_tid(), wid = __builtin_amdgcn_readfirstlane(tid >> 6), lane = tid & 63, wr = wid >> 2, wc = wid & 3, fr = lane & 15, fq = lane >> 4;
    const int K = g.K, nt = K / BK;
    unsigned voffA[2], voffB[2];
#pragma unroll
    for (int i = 0; i < 2; ++i) { int R, C; stage_rc(tid * 16 + i * 8192, R, C); const int Rb = Epi::PERM ? ((R & ~31) + perm32(R & 31)) : R;
        voffA[i] = (unsigned)(R * K + C) * 2u; voffB[i] = (unsigned)(Rb * K + C) * 2u; }
    const size_t kstep = (size_t)(BK * 2);
    const size_t hstep = (size_t)HALF * K * 2;
    const size_t tstep = 2 * hstep;
    const unsigned ldsw = (unsigned)wid * 1024u;
    const int aoff = lds_byte(wr * 64 + fr, fq * 8), boff = lds_byte(wc * 32 + fr, fq * 8);
#define PG8_SA(b, h) (((b) * 2 + (h)) * HTB)
#define PG8_SB(b, h) ((4 + (b) * 2 + (h)) * HTB)
#define PG8_STAGE(bufoff, gbase, voff) do { _Pragma("unroll") for (int _i = 0; _i < 2; ++_i) \
        __builtin_amdgcn_global_load_lds((const unsigned*)((const char*)(gbase) + (voff)[_i]), (LAS unsigned*)(lds + (bufoff) + ldsw + _i * 8192), 16, 0, 0); } while (0)
#define PG8_LDA(dst, b, h) do { _Pragma("unroll") for (int m = 0; m < 4; ++m) _Pragma("unroll") for (int k = 0; k < 2; ++k) dst[m][k] = *(const LAS bf16x8*)(lds + PG8_SA(b, h) + aoff + m * 2048 + k * 1024); } while (0)
#define PG8_LDB(dst, b, h) do { _Pragma("unroll") for (int n = 0; n < 2; ++n) _Pragma("unroll") for (int k = 0; k < 2; ++k) dst[n][k] = *(const LAS bf16x8*)(lds + PG8_SB(b, h) + boff + n * 2048 + k * 1024); } while (0)
#define PG8_MMA(ai, bj, At, Bt) do { __builtin_amdgcn_s_setprio(1); _Pragma("unroll") for (int m = 0; m < 4; ++m) _Pragma("unroll") for (int n = 0; n < 2; ++n) _Pragma("unroll") for (int k = 0; k < 2; ++k) \
        { if constexpr (Epi::I8) acc[ai][bj][m][n] = __builtin_bit_cast(acc_t, __builtin_amdgcn_mfma_i32_16x16x64_i8(__builtin_bit_cast(i32x4, Bt[n][k]), __builtin_bit_cast(i32x4, At[m][k]), __builtin_bit_cast(i32x4, acc[ai][bj][m][n]), 0, 0, 0)); \
          else acc[ai][bj][m][n] = __builtin_bit_cast(acc_t, __builtin_amdgcn_mfma_f32_16x16x32_bf16(Bt[n][k], At[m][k], __builtin_bit_cast(f32x4, acc[ai][bj][m][n]), 0, 0, 0)); } __builtin_amdgcn_s_setprio(0); } while (0)
#define PG8_WAIT_V(n) asm volatile("s_waitcnt vmcnt(" #n ")" ::: "memory")
#define PG8_WAIT_L(n) asm volatile("s_waitcnt lgkmcnt(" #n ")" ::: "memory")
#define PG8_BAR __builtin_amdgcn_s_barrier()
#define PG8_SCHED __builtin_amdgcn_sched_barrier(0)
    Unit cur, nxt; int ui = 0;
    if (!S.next(0, cur)) return;
    typedef typename Epi::acc_t acc_t;
    acc_t acc[2][2][4][2];
#pragma unroll
    for (int a = 0; a < 2; ++a)
#pragma unroll
        for (int b = 0; b < 2; ++b)
#pragma unroll
            for (int m = 0; m < 4; ++m)
#pragma unroll
                for (int n = 0; n < 2; ++n) acc[a][b][m][n] = (acc_t){0, 0, 0, 0};
    bf16x8 At[4][2], B0[2][2], B1[2][2];
    const char* cA = (const char*)g.A + (size_t)cur.pm * tstep; const char* cB = (const char*)g.Bt + (size_t)cur.pn * tstep;
    PG8_STAGE(PG8_SB(0, 0), cB, voffB); PG8_STAGE(PG8_SA(0, 0), cA, voffA); PG8_STAGE(PG8_SB(0, 1), cB + hstep, voffB); PG8_STAGE(PG8_SA(0, 1), cA + hstep, voffA);
    if (wr == 1) PG8_BAR;
    PG8_WAIT_V(4); PG8_BAR;
    PG8_STAGE(PG8_SB(1, 0), cB + kstep, voffB); PG8_STAGE(PG8_SA(1, 0), cA + kstep, voffA); PG8_STAGE(PG8_SB(1, 1), cB + hstep + kstep, voffB);
    PG8_WAIT_V(6); PG8_BAR;
    for (;;) {
        const bool has_next = S.next(ui + 1, nxt);
        const char* nA = has_next ? (const char*)g.A + (size_t)nxt.pm * tstep : cA; const char* nB = has_next ? (const char*)g.Bt + (size_t)nxt.pn * tstep : cB;
        for (int t = 0; t < nt; t += 2) {
            const bool last = (t == nt - 2);
            const char* a1 = cA + (size_t)(t + 1) * kstep;
            const char* a2 = last ? nA : cA + (size_t)(t + 2) * kstep; const char* b2 = last ? nB : cB + (size_t)(t + 2) * kstep;
            const char* a3 = a2 + kstep; const char* b3 = b2 + kstep;
            if constexpr (Epi::MID) { if (t == nt / 2) E.mid(acc, cur, wr, wc, fr, fq); }
            PG8_LDB(B0, 0, 0); PG8_SCHED; PG8_LDA(At, 0, 0); PG8_STAGE(PG8_SA(1, 1), a1 + hstep, voffA);
            PG8_WAIT_L(8); PG8_BAR; PG8_WAIT_L(0); PG8_MMA(0, 0, At, B0); PG8_BAR; PG8_SCHED;
            PG8_LDB(B1, 0, 1); PG8_STAGE(PG8_SB(0, 0), b2, voffB);
            PG8_BAR; PG8_WAIT_L(0); PG8_MMA(0, 1, At, B1); PG8_BAR;
            PG8_LDA(At, 0, 1); PG8_STAGE(PG8_SA(0, 0), a2, voffA);
            PG8_BAR; PG8_WAIT_L(0); PG8_MMA(1, 0, At, B0); PG8_BAR; PG8_SCHED;
            PG8_STAGE(PG8_SB(0, 1), b2 + hstep, voffB);
            PG8_WAIT_V(6); PG8_BAR; PG8_MMA(1, 1, At, B1); PG8_BAR;
            PG8_LDB(B0, 1, 0); PG8_SCHED; PG8_LDA(At, 1, 0); PG8_STAGE(PG8_SA(0, 1), a2 + hstep, voffA);
            PG8_WAIT_L(8); PG8_BAR; PG8_WAIT_L(0); PG8_MMA(0, 0, At, B0); PG8_BAR; PG8_SCHED;
            PG8_LDB(B1, 1, 1); PG8_STAGE(PG8_SB(1, 0), b3, voffB);
            PG8_BAR; PG8_WAIT_L(0); PG8_MMA(0, 1, At, B1); PG8_BAR;
            PG8_LDA(At, 1, 1); PG8_STAGE(PG8_SA(1, 0), a3, voffA);
            PG8_BAR; PG8_WAIT_L(0); PG8_MMA(1, 0, At, B0); PG8_BAR; PG8_SCHED;
            PG8_STAGE(PG8_SB(1, 1), b3 + hstep, voffB);
            PG8_WAIT_V(6); PG8_BAR; PG8_MMA(1, 1, At, B1); PG8_BAR;
        }
        E(acc, cur, wr, wc, fr, fq);
        if (!has_next) break;
#pragma unroll
        for (int a = 0; a < 2; ++a)
#pragma unroll
            for (int b = 0; b < 2; ++b)
#pragma unroll
                for (int m = 0; m < 4; ++m)
#pragma unroll
                    for (int n = 0; n < 2; ++n) acc[a][b][m][n] = (acc_t){0, 0, 0, 0};
        cur = nxt; cA = nA; cB = nB; ++ui;
    }
    PG8_WAIT_V(0);
    if (wr == 0) PG8_BAR;
    PG8_BAR;
#undef PG8_SA
#undef PG8_SB
#undef PG8_STAGE
#undef PG8_LDA
#undef PG8_LDB
#undef PG8_MMA
#undef PG8_WAIT_V
#undef PG8_WAIT_L
#undef PG8_BAR
#undef PG8_SCHED
}
}

struct EpiProj {
    typedef i32x4 acc_t; static constexpr bool PERM = true, MID = false, I8 = true;
    unsigned char* ws;
    __device__ __forceinline__ void operator()(const i32x4 (&iacc)[2][2][4][2], const pg8::Unit& u, int wr, int wc, int fr, int fq) const {
        const int row0 = u.pm * 256 + wr * 64 + fr, pn = u.pn;
        f32x4 acc[2][2][4][2];
        { const float* shs = (const float*)(ws + WS_SH); const float* sws = (const float*)(ws + WS_SW);
          f32x4 cw[2][2];
#pragma unroll
          for (int bj = 0; bj < 2; ++bj)
#pragma unroll
              for (int n = 0; n < 2; ++n) cw[bj][n] = *(const f32x4*)(sws + pn * 256 + bj * 128 + wc * 32 + 8 * fq + 4 * n);
#pragma unroll
          for (int ai = 0; ai < 2; ++ai)
#pragma unroll
              for (int m = 0; m < 4; ++m) { const float rs = shs[row0 + ai * 128 + m * 16];
#pragma unroll
                  for (int bj = 0; bj < 2; ++bj)
#pragma unroll
                      for (int n = 0; n < 2; ++n)
#pragma unroll
                          for (int j = 0; j < 4; ++j) acc[ai][bj][m][n][j] = (float)iacc[ai][bj][m][n][j] * rs * cw[bj][n][j]; } }
        const int cin = wc * 32 + 8 * fq;
        int seg, cbase;
        if (pn < 28) { seg = pn >> 2; cbase = (pn & 3) * 256; } else if (pn < 36) { seg = 7; cbase = (pn - 28) * 256; } else { seg = 8; cbase = (pn - 36) * 256; }
        if (seg == 2) {
            bf16_t* vt = (bf16_t*)(ws + WS_VT);
#pragma unroll
            for (int ai = 0; ai < 2; ++ai)
#pragma unroll
                for (int m = 0; m < 4; ++m) {
                    const int row = row0 + ai * 128 + m * 16, b = row / SEQ, s = row % SEQ;
#pragma unroll
                    for (int bj = 0; bj < 2; ++bj) {
                        const int c = cbase + bj * 128 + cin, h = c >> 7, d = c & 127;
                        bf16_t* dst = vt + ((size_t)((b * NH + h) * HD + d)) * SEQ + s;
#pragma unroll
                        for (int n = 0; n < 2; ++n)
#pragma unroll
                            for (int j = 0; j < 4; ++j) dst[(size_t)(n * 4 + j) * SEQ] = f2bf(acc[ai][bj][m][n][j]);
                    }
                }
            return;
        }
        bf16_t* base; int ldc;
        switch (seg) {
            case 0: base = (bf16_t*)(ws + WS_Q); ldc = HW; break;
            case 1: base = (bf16_t*)(ws + WS_K); ldc = HW; break;
            case 3: base = (bf16_t*)(ws + WS_HQ); ldc = HW; break;
            case 4: base = (bf16_t*)(ws + WS_HF); ldc = HW; break;
            case 5: base = (bf16_t*)(ws + WS_HI); ldc = HW; break;
            case 6: base = (bf16_t*)(ws + WS_HG); ldc = HW; break;
            case 7: base = (bf16_t*)(ws + WS_GA); ldc = DM; break;
            default: base = (bf16_t*)(ws + WS_GB); ldc = DM; break;
        }
        const float qs = 0.08838834764831845f * LOG2E;
#pragma unroll
        for (int ai = 0; ai < 2; ++ai)
#pragma unroll
            for (int m = 0; m < 4; ++m) {
                bf16_t* rowp = base + (size_t)(row0 + ai * 128 + m * 16) * ldc + cbase + cin;
#pragma unroll
                for (int bj = 0; bj < 2; ++bj) {
                    f32x4 v0 = acc[ai][bj][m][0], v1 = acc[ai][bj][m][1];
                    if (seg == 0) { v0 *= qs; v1 *= qs; }
                    else if (seg == 6) {
#pragma unroll
                        for (int j = 0; j < 4; ++j) { v0[j] = siluf_(v0[j]); v1[j] = siluf_(v1[j]); }
                    } else if (seg >= 7) {
#pragma unroll
                        for (int j = 0; j < 4; ++j) { v0[j] = sigmoidf_(v0[j]); v1[j] = sigmoidf_(v1[j]); }
                    }
                    u32x4 w; w.x = pk2(v0[0], v0[1]); w.y = pk2(v0[2], v0[3]); w.z = pk2(v1[0], v1[1]); w.w = pk2(v1[2], v1[3]);
                    *(u32x4*)(rowp + bj * 128) = w;
                }
            }
    }
};
struct EpiT1 {
    typedef f32x4 acc_t; static constexpr bool PERM = true, MID = false, I8 = false;
    unsigned char* ws;
    __device__ __forceinline__ void operator()(const f32x4 (&acc)[2][2][4][2], const pg8::Unit& u, int wr, int wc, int fr, int fq) const {
        const int row0 = u.pm * 256 + wr * 64 + fr, col0 = u.pn * 256 + wc * 32 + 8 * fq;
        const bf16_t* ga = (const bf16_t*)(ws + WS_GA); float* t1 = (float*)(ws + WS_R1);
#pragma unroll
        for (int ai = 0; ai < 2; ++ai)
#pragma unroll
            for (int m = 0; m < 4; ++m)
#pragma unroll
                for (int bj = 0; bj < 2; ++bj) {
                    const size_t off = (size_t)(row0 + ai * 128 + m * 16) * DM + col0 + bj * 128;
                    const u32x4 g = *(const u32x4*)(ga + off);
                    f32x4 v0 = acc[ai][bj][m][0], v1 = acc[ai][bj][m][1];
                    v0[0] *= bf_lo(g.x); v0[1] *= bf_hi(g.x); v0[2] *= bf_lo(g.y); v0[3] *= bf_hi(g.y);
                    v1[0] *= bf_lo(g.z); v1[1] *= bf_hi(g.z); v1[2] *= bf_lo(g.w); v1[3] *= bf_hi(g.w);
                    *(f32x4*)(t1 + off) = v0; *(f32x4*)(t1 + off + 4) = v1;
                }
    }
};
struct EpiMerge {
    typedef f32x4 acc_t; static constexpr bool PERM = true, MID = false, I8 = false;
    unsigned char* ws;
    __device__ __forceinline__ void operator()(const f32x4 (&acc)[2][2][4][2], const pg8::Unit& u, int wr, int wc, int fr, int fq) const {
        const int row0 = u.pm * 256 + wr * 64 + fr, col0 = u.pn * 256 + wc * 32 + 8 * fq;
        const bf16_t* gb = (const bf16_t*)(ws + WS_GB); const float* t1 = (const float*)(ws + WS_R1); bf16_t* mg = (bf16_t*)(ws + WS_MERGED);
#pragma unroll
        for (int ai = 0; ai < 2; ++ai)
#pragma unroll
            for (int m = 0; m < 4; ++m)
#pragma unroll
                for (int bj = 0; bj < 2; ++bj) {
                    const size_t off = (size_t)(row0 + ai * 128 + m * 16) * DM + col0 + bj * 128;
                    const u32x4 g = *(const u32x4*)(gb + off);
                    f32x4 v0 = acc[ai][bj][m][0], v1 = acc[ai][bj][m][1];
                    const f32x4 t0 = *(const f32x4*)(t1 + off), t4 = *(const f32x4*)(t1 + off + 4);
                    v0[0] = v0[0] * bf_lo(g.x) + t0[0]; v0[1] = v0[1] * bf_hi(g.x) + t0[1]; v0[2] = v0[2] * bf_lo(g.y) + t0[2]; v0[3] = v0[3] * bf_hi(g.y) + t0[3];
                    v1[0] = v1[0] * bf_lo(g.z) + t4[0]; v1[1] = v1[1] * bf_hi(g.z) + t4[1]; v1[2] = v1[2] * bf_lo(g.w) + t4[2]; v1[3] = v1[3] * bf_hi(g.w) + t4[3];
                    u32x4 w; w.x = pk2(v0[0], v0[1]); w.y = pk2(v0[2], v0[3]); w.z = pk2(v1[0], v1[1]); w.w = pk2(v1[2], v1[3]);
                    *(u32x4*)(mg + off) = w;
                }
    }
};
struct EpiRes1 {
    typedef f32x4 acc_t; static constexpr bool PERM = true, MID = false, I8 = false;
    unsigned char* ws; const float* x;
    __device__ __forceinline__ void operator()(const f32x4 (&acc)[2][2][4][2], const pg8::Unit& u, int wr, int wc, int fr, int fq) const {
        const int row0 = u.pm * 256 + wr * 64 + fr, col0 = u.pn * 256 + wc * 32 + 8 * fq;
        const float* mod = (const float*)(ws + WS_MOD); bf16_t* r1 = (bf16_t*)(ws + WS_R1);
        const int b = (u.pm * 256) / SEQ;
        f32x4 g1[2][2];
#pragma unroll
        for (int bj = 0; bj < 2; ++bj)
#pragma unroll
            for (int n = 0; n < 2; ++n) g1[bj][n] = 1.f + *(const f32x4*)(mod + b * 6 * DM + 2 * DM + col0 + bj * 128 + 4 * n);
#pragma unroll
        for (int ai = 0; ai < 2; ++ai)
#pragma unroll
            for (int m = 0; m < 4; ++m) {
                const size_t ro = (size_t)(row0 + ai * 128 + m * 16) * DM + col0;
#pragma unroll
                for (int bj = 0; bj < 2; ++bj) {
                    const f32x4 x0 = *(const f32x4*)(x + ro + bj * 128), x1 = *(const f32x4*)(x + ro + bj * 128 + 4);
                    const f32x4 v0 = ALPHA * x0 + g1[bj][0] * acc[ai][bj][m][0], v1 = ALPHA * x1 + g1[bj][1] * acc[ai][bj][m][1];
                    u32x4 w; w.x = pk2(v0[0], v0[1]); w.y = pk2(v0[2], v0[3]); w.z = pk2(v1[0], v1[1]); w.w = pk2(v1[2], v1[3]);
                    *(u32x4*)(r1 + ro + bj * 128) = w;
                }
            }
    }
};
struct EpiQP {
    typedef f32x4 acc_t; static constexpr bool PERM = true, MID = false, I8 = false;
    unsigned char* ws;
    __device__ __forceinline__ void operator()(const f32x4 (&acc)[2][2][4][2], const pg8::Unit& u, int wr, int wc, int fr, int fq) const {
        const int row0 = u.pm * 256 + wr * 64 + fr, col0 = u.pn * 256 + wc * 32 + 8 * fq;
        bf16_t* qp = (bf16_t*)(ws + WS_QP);
#pragma unroll
        for (int ai = 0; ai < 2; ++ai)
#pragma unroll
            for (int m = 0; m < 4; ++m)
#pragma unroll
                for (int bj = 0; bj < 2; ++bj) {
                    const size_t off = (size_t)(row0 + ai * 128 + m * 16) * DM + col0 + bj * 128;
                    const f32x4 v0 = acc[ai][bj][m][0], v1 = acc[ai][bj][m][1];
                    u32x4 w; w.x = pk2(v0[0], v0[1]); w.y = pk2(v0[2], v0[3]); w.z = pk2(v1[0], v1[1]); w.w = pk2(v1[2], v1[3]);
                    *(u32x4*)(qp + off) = w;
                }
    }
};

struct EpiMerge2 {
    typedef f32x4 acc_t; static constexpr bool PERM = true, MID = true, I8 = false;
    unsigned char* ws;
    __device__ __forceinline__ void mid(f32x4 (&acc)[2][2][4][2], const pg8::Unit& u, int wr, int wc, int fr_in, int fq) const {
        int fr = fr_in; asm volatile("" : "+v"(fr));
        const int row0 = u.pm * 256 + wr * 64 + fr, col0 = u.pn * 256 + wc * 32 + 8 * fq;
        const bf16_t* ga = (const bf16_t*)(ws + WS_GA); const bf16_t* gb = (const bf16_t*)(ws + WS_GB);
#pragma unroll
        for (int ai = 0; ai < 2; ++ai)
#pragma unroll
            for (int m = 0; m < 4; ++m)
#pragma unroll
                for (int bj = 0; bj < 2; ++bj) {
                    const size_t off = (size_t)(row0 + ai * 128 + m * 16) * DM + col0 + bj * 128;
                    const u32x4 a = *(const u32x4*)(ga + off), b = *(const u32x4*)(gb + off);
                    const unsigned aw[4] = {a.x, a.y, a.z, a.w}, bw[4] = {b.x, b.y, b.z, b.w};
#pragma unroll
                    for (int q = 0; q < 4; ++q) {
                        const float r0 = bf_lo(aw[q]) * fast_rcp(fmaxf(bf_lo(bw[q]), 1e-20f)), r1 = bf_hi(aw[q]) * fast_rcp(fmaxf(bf_hi(bw[q]), 1e-20f));
                        acc[ai][bj][m][q >> 1][2 * (q & 1)] *= r0; acc[ai][bj][m][q >> 1][2 * (q & 1) + 1] *= r1;
                    }
                    asm volatile("" ::: "memory");
                }
    }
    __device__ __forceinline__ void operator()(const f32x4 (&acc)[2][2][4][2], const pg8::Unit& u, int wr, int wc, int fr, int fq) const {
        const int row0 = u.pm * 256 + wr * 64 + fr, col0 = u.pn * 256 + wc * 32 + 8 * fq;
        const bf16_t* gb = (const bf16_t*)(ws + WS_GB); bf16_t* mg = (bf16_t*)(ws + WS_MERGED);
#pragma unroll
        for (int ai = 0; ai < 2; ++ai)
#pragma unroll
            for (int m = 0; m < 4; ++m)
#pragma unroll
                for (int bj = 0; bj < 2; ++bj) {
                    const size_t off = (size_t)(row0 + ai * 128 + m * 16) * DM + col0 + bj * 128;
                    const u32x4 g = *(const u32x4*)(gb + off);
                    const f32x4 v0 = acc[ai][bj][m][0], v1 = acc[ai][bj][m][1];
                    u32x4 w;
                    w.x = pk2(v0[0] * fmaxf(bf_lo(g.x), 1e-20f), v0[1] * fmaxf(bf_hi(g.x), 1e-20f)); w.y = pk2(v0[2] * fmaxf(bf_lo(g.y), 1e-20f), v0[3] * fmaxf(bf_hi(g.y), 1e-20f));
                    w.z = pk2(v1[0] * fmaxf(bf_lo(g.z), 1e-20f), v1[1] * fmaxf(bf_hi(g.z), 1e-20f)); w.w = pk2(v1[2] * fmaxf(bf_lo(g.w), 1e-20f), v1[3] * fmaxf(bf_hi(g.w), 1e-20f));
                    *(u32x4*)(mg + off) = w;
                }
    }
};

struct EpiQP8 {
    typedef i32x4 acc_t; static constexpr bool PERM = true, MID = false, I8 = true;
    unsigned char* ws;
    __device__ __forceinline__ void operator()(const i32x4 (&acc)[2][2][4][2], const pg8::Unit& u, int wr, int wc, int fr, int fq) const {
        const int row0 = u.pm * 256 + wr * 64 + fr, col0 = u.pn * 256 + wc * 32 + 8 * fq;
        bf16_t* qp = (bf16_t*)(ws + WS_QP); const float* shs = (const float*)(ws + WS_SH2); const float* sws = (const float*)(ws + WS_SWQ);
        f32x4 cw[2][2];
#pragma unroll
        for (int bj = 0; bj < 2; ++bj)
#pragma unroll
            for (int n = 0; n < 2; ++n) cw[bj][n] = *(const f32x4*)(sws + col0 + bj * 128 + 4 * n);
#pragma unroll
        for (int ai = 0; ai < 2; ++ai)
#pragma unroll
            for (int m = 0; m < 4; ++m) {
                const float rs = shs[row0 + ai * 128 + m * 16];
#pragma unroll
                for (int bj = 0; bj < 2; ++bj) {
                    const size_t off = (size_t)(row0 + ai * 128 + m * 16) * DM + col0 + bj * 128;
                    float v[8];
#pragma unroll
                    for (int n = 0; n < 2; ++n)
#pragma unroll
                        for (int j = 0; j < 4; ++j) v[4 * n + j] = (float)acc[ai][bj][m][n][j] * rs * cw[bj][n][j];
                    u32x4 w; w.x = pk2(v[0], v[1]); w.y = pk2(v[2], v[3]); w.z = pk2(v[4], v[5]); w.w = pk2(v[6], v[7]);
                    *(u32x4*)(qp + off) = w;
                }
            }
    }
};
constexpr float ATT_EXIT = -150.f;
constexpr int ATT_KS_BYTES = 64 * 256, ATT_VT_STRIDE = 136, ATT_VT_BYTES = 128 * ATT_VT_STRIDE;
__device__ __forceinline__ void phase_attn(const Params& p, LAS unsigned char* lds, int wg, int G) {
    const int tid = opaque_tid(), w = __builtin_amdgcn_readfirstlane(tid >> 6), lane = tid & 63, l31 = lane & 31, h2 = lane >> 5;
    const bf16_t* Qg = (const bf16_t*)(p.ws + WS_Q); const bf16_t* Kg = (const bf16_t*)(p.ws + WS_K); const bf16_t* VTg = (const bf16_t*)(p.ws + WS_VT);
    bf16_t* AO = (bf16_t*)(p.ws + WS_AB);
    LAS unsigned char* KsB[2] = {lds, lds + ATT_KS_BYTES};
    LAS unsigned char* VtB[2] = {lds + 2 * ATT_KS_BYTES, lds + 2 * ATT_KS_BYTES + ATT_VT_BYTES};
    volatile LAS int* flags = (volatile LAS int*)(lds + 2 * ATT_KS_BYTES + 2 * ATT_VT_BYTES);
    for (int item = wg; item < NB * NH * 16; item += G) {
        const int bh = item >> 4, qb = item & 15, b = bh >> 3, h = bh & 7, t0 = qb * 256;
        const int tq = t0 + 32 * w + l31;
        const int tq_hi = t0 + 32 * w + 31;
        bf16x8 qf[8];
        { const bf16_t* qrow = Qg + (size_t)(b * SEQ + tq) * HW + h * HD + h2 * 8;
#pragma unroll
          for (int ks = 0; ks < 8; ++ks) qf[ks] = *(const bf16x8*)(qrow + ks * 16); }
        f32x16 o[4];
#pragma unroll
        for (int i = 0; i < 4; ++i)
#pragma unroll
            for (int r = 0; r < 16; ++r) o[i][r] = 0.f;
        float R = 0.f;
        bool wdone = false;
        const int kt_first = (t0 + 256) / 64 - 1;
        u32x4 kreg[2], vreg[2];
        const bf16_t* Kbase = Kg + (size_t)(b * SEQ) * HW + h * HD;
        const bf16_t* Vbase = VTg + (size_t)(bh * HD) * SEQ;
        auto prefetch = [&](int kt) {
#pragma unroll
            for (int i = 0; i < 2; ++i) {
                const int id = tid + i * NTHR;
                const int kr = id >> 4, kc = id & 15;
                kreg[i] = *(const u32x4*)(Kbase + (size_t)(kt * 64 + kr) * HW + kc * 8);
                const int vr = id >> 3, vc = id & 7;
                vreg[i] = *(const u32x4*)(Vbase + (size_t)vr * SEQ + kt * 64 + vc * 8);
            }
        };
        prefetch(kt_first);
        __syncthreads();
        if (tid < 16) flags[tid] = 0;
        int it = 0;
        for (int kt = kt_first; kt >= 0; --kt, ++it) {
            const int cur = it & 1;
#pragma unroll
            for (int i = 0; i < 2; ++i) {
                const int id = tid + i * NTHR;
                const int kr = id >> 4, kc = id & 15;
                *(LAS u32x4*)(KsB[cur] + kr * 256 + ((kc ^ (kr & 15)) << 4)) = kreg[i];
                const int vr = id >> 3, vc = id & 7;
                LAS unsigned char* vd = VtB[cur] + vr * ATT_VT_STRIDE + vc * 16;
                *(LAS u32x2*)vd = (u32x2){vreg[i].x, vreg[i].y}; *(LAS u32x2*)(vd + 8) = (u32x2){vreg[i].z, vreg[i].w};
            }
            __syncthreads();
            if (it > 0) {
                int alld = 1;
#pragma unroll
                for (int j = 0; j < 8; ++j) alld &= flags[((it - 1) & 1) * 8 + j];
                if (alld) break;
            }
            if (kt > 0) prefetch(kt - 1);
            const bool active = !wdone && (kt * 64 < tq_hi);
            if (active) {
#pragma unroll
                for (int kbi = 0; kbi < 2; ++kbi) {
                    const int kb = 1 - kbi;
                    const int key0 = kt * 64 + kb * 32;
                    if (key0 < tq_hi) {
                        f32x16 S;
#pragma unroll
                        for (int r = 0; r < 16; ++r) S[r] = 0.f;
                        const int krow = kb * 32 + l31;
                        const LAS unsigned char* kp = KsB[cur] + krow * 256;
#pragma unroll
                        for (int ks = 0; ks < 8; ++ks) {
                            const bf16x8 a = *(const LAS bf16x8*)(kp + (((ks * 2 + h2) ^ (krow & 15)) << 4));
                            S = __builtin_amdgcn_mfma_f32_32x32x16_bf16(a, qf[ks], S, 0, 0, 0);
                        }
                        float lg[16], zb[16];
#pragma unroll
                        for (int r = 0; r < 16; ++r) {
                            const int key = key0 + (r & 3) + 8 * (r >> 2) + 4 * h2;
                            const float z = S[r];
                            const float sp = fmaxf(z, 0.f) + fast_log2(1.f + fast_exp2(-fabsf(z)));
                            const bool valid = key < tq;
                            lg[r] = valid ? -sp : 0.f;
                            zb[r] = valid ? (z - sp) : -INFINITY;
                        }
                        float g[4], pg[4], tot[4];
#pragma unroll
                        for (int i = 0; i < 4; ++i) { g[i] = (lg[4 * i] + lg[4 * i + 1]) + (lg[4 * i + 2] + lg[4 * i + 3]); pg[i] = __shfl_xor(g[i], 32); tot[i] = g[i] + pg[i]; }
                        float above[4]; above[3] = 0.f; above[2] = tot[3]; above[1] = tot[3] + tot[2]; above[0] = above[1] + tot[1];
                        unsigned wp[8];
#pragma unroll
                        for (int i = 0; i < 4; ++i) {
                            const float off = R + above[i] + (h2 == 0 ? pg[i] : 0.f);
                            const float c3 = off, c2 = c3 + lg[4 * i + 3], c1 = c2 + lg[4 * i + 2], c0 = c1 + lg[4 * i + 1];
                            const float w0 = fast_exp2(zb[4 * i] + c0), w1 = fast_exp2(zb[4 * i + 1] + c1), w2 = fast_exp2(zb[4 * i + 2] + c2), w3 = fast_exp2(zb[4 * i + 3] + c3);
                            wp[2 * i] = pk2(w0, w1); wp[2 * i + 1] = pk2(w2, w3);
                        }
                        R += (tot[0] + tot[1]) + (tot[2] + tot[3]);
#pragma unroll
                        for (int s2 = 0; s2 < 2; ++s2) {
                            bf16x8 bw;
                            { u32x4 t; t.x = wp[4 * s2]; t.y = wp[4 * s2 + 1]; t.z = wp[4 * s2 + 2]; t.w = wp[4 * s2 + 3]; bw = __builtin_bit_cast(bf16x8, t); }
                            const int kk = kb * 32 + 16 * s2 + 4 * h2;
#pragma unroll
                            for (int db = 0; db < 4; ++db) {
                                const LAS unsigned char* vp = VtB[cur] + (db * 32 + l31) * ATT_VT_STRIDE + kk * 2;
                                const u32x2 lo = *(const LAS u32x2*)vp, hi = *(const LAS u32x2*)(vp + 16);
                                u32x4 t; t.x = lo.x; t.y = lo.y; t.z = hi.x; t.w = hi.y;
                                o[db] = __builtin_amdgcn_mfma_f32_32x32x16_bf16(__builtin_bit_cast(bf16x8, t), bw, o[db], 0, 0, 0);
                            }
                        }
                    }
                }
                if (__all(R < ATT_EXIT)) wdone = true;
            }
            if (lane == 0) flags[cur * 8 + w] = wdone ? 1 : 0;
        }
        { bf16_t* orow = AO + (size_t)(b * SEQ + tq) * DM + h * HD;
#pragma unroll
          for (int db = 0; db < 4; ++db)
#pragma unroll
              for (int i = 0; i < 4; ++i) {
                  u32x2 v; v.x = pk2(o[db][4 * i], o[db][4 * i + 1]); v.y = pk2(o[db][4 * i + 2], o[db][4 * i + 3]);
                  *(u32x2*)(orow + db * 32 + 8 * i + 4 * h2) = v;
              } }
    }
    __syncthreads();
}

constexpr int HG_SEGC = 4, HG_NSEG = 16;
constexpr int HG_OFF_AS = 0, HG_OFF_KP = HG_OFF_AS + 64 * 272, HG_OFF_KT = HG_OFF_KP + 64 * 272, HG_OFF_VT = HG_OFF_KT + 128 * 144,
              HG_OFF_PS = HG_OFF_VT + 128 * 144, HG_OFF_ST = HG_OFF_PS + 64 * 144, HG_OFF_GAM = HG_OFF_ST + 128 * 272,
              HG_OFF_RS = HG_OFF_GAM + 512, HG_OFF_GSEG = HG_OFF_RS + 512, HG_OFF_LBS = HG_OFF_GSEG + 512, HG_LDS_END = HG_OFF_LBS + 512;
template <int PASS>
__device__ __forceinline__ void phase_hgrn(const Params& p, LAS unsigned char* lds, int wg, int G) {
    const int tid = opaque_tid(), w = __builtin_amdgcn_readfirstlane(tid >> 6), lane = tid & 63, fr = lane & 15, fq = lane >> 4;
    LAS unsigned char* As = lds + HG_OFF_AS; LAS unsigned char* Kp = lds + HG_OFF_KP; LAS unsigned char* KT = lds + HG_OFF_KT;
    LAS unsigned char* VT = lds + HG_OFF_VT; LAS unsigned char* Ps = lds + HG_OFF_PS; LAS unsigned char* ST = lds + HG_OFF_ST;
    LAS float* gam = (LAS float*)(lds + HG_OFF_GAM); LAS float* rs = (LAS float*)(lds + HG_OFF_RS);
    LAS float* gseg = (LAS float*)(lds + HG_OFF_GSEG); LAS float* lbs = (LAS float*)(lds + HG_OFF_LBS);
    const bf16_t* HQ = (const bf16_t*)(p.ws + WS_HQ); const bf16_t* HF = (const bf16_t*)(p.ws + WS_HF); const bf16_t* HI = (const bf16_t*)(p.ws + WS_HI);
    const bf16_t* HGs = (const bf16_t*)(p.ws + WS_HG); bf16_t* BO = (bf16_t*)(p.ws + WS_AB) + HW;
    const float* lbv = (const float*)(p.ws + WS_LB);
    float* HST = (float*)(p.ws + WS_HST); float* HGAM = (float*)(p.ws + WS_HGAM);
    for (int item = wg; item < NB * NH * HG_NSEG; item += G) {
        const int bh = item / HG_NSEG, seg = item % HG_NSEG, b = bh >> 3, h = bh & 7;
        f32x4 S[8];
#pragma unroll
        for (int eb = 0; eb < 8; ++eb) S[eb] = (f32x4){0.f, 0.f, 0.f, 0.f};
        __syncthreads();
        u32x4 pq[2], pf[2], pv[2];
        { const int tokf = b * SEQ + (seg * HG_SEGC) * 64;
#pragma unroll
          for (int i = 0; i < 2; ++i) {
              const size_t go = (size_t)(tokf + lane) * HW + h * HD + (w + 8 * i) * 8;
              pq[i] = *(const u32x4*)(HQ + go); pf[i] = *(const u32x4*)(HF + go); pv[i] = *(const u32x4*)(HI + go);
          } }
        if (tid < 128) { lbs[tid] = lbv[h * HD + tid]; if (PASS == 0) gseg[tid] = 1.f; }
        if (PASS == 1) {
            f32x4 P4 = {1.f, 1.f, 1.f, 1.f};
            for (int j = seg - 1; j >= 0; --j) {
                const float* Lj = HST + (size_t)(bh * HG_NSEG + j) * (HD * HD);
#pragma unroll
                for (int eb = 0; eb < 8; ++eb)
#pragma unroll
                    for (int jj = 0; jj < 4; ++jj) S[eb][jj] += P4[jj] * Lj[(size_t)(w * 16 + 4 * fq + jj) * HD + eb * 16 + fr];
                P4 *= *(const f32x4*)(HGAM + (size_t)(bh * HG_NSEG + j) * HD + w * 16 + 4 * fq);
                if (__all(P4[0] == 0.f && P4[1] == 0.f && P4[2] == 0.f && P4[3] == 0.f)) break;
            }
#pragma unroll
            for (int eb = 0; eb < 8; ++eb) { u32x2 v; v.x = pk2(S[eb][0], S[eb][1]); v.y = pk2(S[eb][2], S[eb][3]); *(LAS u32x2*)(ST + (eb * 16 + fr) * 272 + (w * 16 + 4 * fq) * 2) = v; }
        }
        f32x4 urv[8];
        { const int urow0 = PASS * (NEXP / 2) + item * (HG_SEGC * 8) + w; if (urow0 < NEXP) utab_load(p, urow0, lane, urv); }
        f32x4 ngv[4];
        if (PASS == 1) {
#pragma unroll
            for (int q = 0; q < 4; ++q) ngv[q] = *(const f32x4*)(p.hg_norm_g + h * HD + (((w & 1) * 4 + q) * 16 + 4 * fq));
        }
        __syncthreads();
        for (int cc = 0; cc < HG_SEGC; ++cc) {
            const int tok0 = b * SEQ + (seg * HG_SEGC + cc) * 64;
            const int urow = PASS * (NEXP / 2) + item * (HG_SEGC * 8) + cc * 8 + w;
            u32x2 ggv[4];
            if (PASS == 1) {
                const int tg_ = tok0 + (w >> 1) * 16 + fr;
#pragma unroll
                for (int q = 0; q < 4; ++q) ggv[q] = *(const u32x2*)(HGs + (size_t)tg_ * HW + h * HD + (((w & 1) * 4 + q) * 16 + 4 * fq));
            }
#pragma unroll
            for (int i = 0; i < 2; ++i) {
                const int t = lane, c8 = w + 8 * i;
                const u32x4 qv = pq[i], fv = pf[i], vv = pv[i];
                const unsigned qa[4] = {qv.x, qv.y, qv.z, qv.w}, fa[4] = {fv.x, fv.y, fv.z, fv.w}, va[4] = {vv.x, vv.y, vv.z, vv.w};
                float av[8], kp[8];
#pragma unroll
                for (int j = 0; j < 8; ++j) {
                    const int d = c8 * 8 + j;
                    const float fp = (j & 1) ? bf_hi(fa[j >> 1]) : bf_lo(fa[j >> 1]);
                    const float lb = lbs[d];
                    const float f = lb + (1.f - lb) * sigmoidf_(fp);
                    float c = f;
                    c *= __int_as_float(__builtin_amdgcn_update_dpp(0x3f800000, __float_as_int(c), 0x111, 0xf, 0xf, false));
                    c *= __int_as_float(__builtin_amdgcn_update_dpp(0x3f800000, __float_as_int(c), 0x112, 0xf, 0xf, false));
                    c *= __int_as_float(__builtin_amdgcn_update_dpp(0x3f800000, __float_as_int(c), 0x114, 0xf, 0xf, false));
                    c *= __int_as_float(__builtin_amdgcn_update_dpp(0x3f800000, __float_as_int(c), 0x118, 0xf, 0xf, false));
                    { const float t0 = __int_as_float(__builtin_amdgcn_readlane(__float_as_int(c), 15)), t1 = __int_as_float(__builtin_amdgcn_readlane(__float_as_int(c), 31)),
                                  t2 = __int_as_float(__builtin_amdgcn_readlane(__float_as_int(c), 47));
                      const float t01 = t0 * t1, t012 = t01 * t2;
                      c *= (lane < 16) ? 1.f : (lane < 32) ? t0 : (lane < 48) ? t01 : t012; }
                    const float cl = __int_as_float(__builtin_amdgcn_readlane(__float_as_int(c), 63));
                    const float r = fast_rcp(fmaxf(c, 1e-30f)), kv = 1.f - f;
                    const float qf = (j & 1) ? bf_hi(qa[j >> 1]) : bf_lo(qa[j >> 1]);
                    av[j] = qf * c; kp[j] = kv * r;
                    *(LAS bf16_t*)(KT + d * 144 + t * 2) = f2bf(kp[j] * cl);
                    const unsigned vb = (j & 1) ? (va[j >> 1] >> 16) : (va[j >> 1] & 0xffffu);
                    *(LAS bf16_t*)(VT + d * 144 + t * 2) = (bf16_t)vb;
                    if (lane == 0) { gam[d] = cl; if (PASS == 0) gseg[d] *= cl; }
                }
                u32x4 o1, o2; o1.x = pk2(av[0], av[1]); o1.y = pk2(av[2], av[3]); o1.z = pk2(av[4], av[5]); o1.w = pk2(av[6], av[7]);
                o2.x = pk2(kp[0], kp[1]); o2.y = pk2(kp[2], kp[3]); o2.z = pk2(kp[4], kp[5]); o2.w = pk2(kp[6], kp[7]);
                if (PASS == 1) { *(LAS u32x4*)(As + t * 272 + c8 * 16) = o1; *(LAS u32x4*)(Kp + t * 272 + c8 * 16) = o2; }
            }
            if (cc + 1 < HG_SEGC) {
#pragma unroll
                for (int i = 0; i < 2; ++i) {
                    const size_t go = (size_t)(tok0 + 64 + lane) * HW + h * HD + (w + 8 * i) * 8;
                    pq[i] = *(const u32x4*)(HQ + go); pf[i] = *(const u32x4*)(HF + go); pv[i] = *(const u32x4*)(HI + go);
                }
            }
            if (urow < NEXP) utab_quant_store(p, urow, lane, urv);
            if (cc + 1 < HG_SEGC && urow + 8 < NEXP) utab_load(p, urow + 8, lane, urv);
            __syncthreads();
            if (PASS == 1) {
                { const int tb = w >> 1;
#pragma unroll
                  for (int q = 0; q < 2; ++q) {
                      const int sb = (w & 1) * 2 + q;
                      f32x4 c = {0.f, 0.f, 0.f, 0.f};
#pragma unroll
                      for (int ks = 0; ks < 4; ++ks) {
                          const bf16x8 a = *(const LAS bf16x8*)(Kp + (sb * 16 + fr) * 272 + (ks * 32 + fq * 8) * 2);
                          const bf16x8 bb = *(const LAS bf16x8*)(As + (tb * 16 + fr) * 272 + (ks * 32 + fq * 8) * 2);
                          c = __builtin_amdgcn_mfma_f32_16x16x32_bf16(a, bb, c, 0, 0, 0);
                      }
                      const int t = tb * 16 + fr, s0 = sb * 16 + 4 * fq;
                      u32x2 v; v.x = pk2(s0 <= t ? c[0] : 0.f, s0 + 1 <= t ? c[1] : 0.f); v.y = pk2(s0 + 2 <= t ? c[2] : 0.f, s0 + 3 <= t ? c[3] : 0.f);
                      *(LAS u32x2*)(Ps + t * 144 + s0 * 2) = v;
                  } }
                __syncthreads();
                { const int tb = w >> 1, eh = w & 1;
                  f32x4 oc[4];
#pragma unroll
                  for (int q = 0; q < 4; ++q) oc[q] = (f32x4){0.f, 0.f, 0.f, 0.f};
#pragma unroll
                  for (int ks = 0; ks < 2; ++ks) {
                      const bf16x8 bb = *(const LAS bf16x8*)(Ps + (tb * 16 + fr) * 144 + (ks * 32 + fq * 8) * 2);
#pragma unroll
                      for (int q = 0; q < 4; ++q) {
                          const bf16x8 a = *(const LAS bf16x8*)(VT + ((eh * 4 + q) * 16 + fr) * 144 + (ks * 32 + fq * 8) * 2);
                          oc[q] = __builtin_amdgcn_mfma_f32_16x16x32_bf16(a, bb, oc[q], 0, 0, 0);
                      }
                  }
#pragma unroll
                  for (int ks = 0; ks < 4; ++ks) {
                      const bf16x8 bb = *(const LAS bf16x8*)(As + (tb * 16 + fr) * 272 + (ks * 32 + fq * 8) * 2);
#pragma unroll
                      for (int q = 0; q < 4; ++q) {
                          const bf16x8 a = *(const LAS bf16x8*)(ST + ((eh * 4 + q) * 16 + fr) * 272 + (ks * 32 + fq * 8) * 2);
                          oc[q] = __builtin_amdgcn_mfma_f32_16x16x32_bf16(a, bb, oc[q], 0, 0, 0);
                      }
                  }
                  float ss = 0.f;
#pragma unroll
                  for (int q = 0; q < 4; ++q) ss += (oc[q][0] * oc[q][0] + oc[q][1] * oc[q][1]) + (oc[q][2] * oc[q][2] + oc[q][3] * oc[q][3]);
                  ss += __shfl_xor(ss, 16); ss += __shfl_xor(ss, 32);
                  if (fq == 0) rs[eh * 64 + tb * 16 + fr] = ss;
                  __syncthreads();
                  const float tot = rs[tb * 16 + fr] + rs[64 + tb * 16 + fr];
                  const float rstd = rsqrtf(tot * (1.f / 128.f) + RMS_EPS);
                  const int tg = tok0 + tb * 16 + fr;
#pragma unroll
                  for (int q = 0; q < 4; ++q) {
                      const int e = (eh * 4 + q) * 16 + 4 * fq;
                      const f32x4 ng = ngv[q];
                      const u32x2 gg = ggv[q];
                      u32x2 v;
                      v.x = pk2(oc[q][0] * rstd * ng[0] * bf_lo(gg.x), oc[q][1] * rstd * ng[1] * bf_hi(gg.x));
                      v.y = pk2(oc[q][2] * rstd * ng[2] * bf_lo(gg.y), oc[q][3] * rstd * ng[3] * bf_hi(gg.y));
                      *(u32x2*)(BO + (size_t)tg * DM + h * HD + e) = v;
                  }
                }
            }
            { const f32x4 g4 = *(const LAS f32x4*)(gam + w * 16 + 4 * fq);
              bf16x8 a[2];
#pragma unroll
              for (int ks = 0; ks < 2; ++ks) a[ks] = *(const LAS bf16x8*)(KT + (w * 16 + fr) * 144 + (ks * 32 + fq * 8) * 2);
#pragma unroll
              for (int eb = 0; eb < 8; ++eb) {
                  f32x4 c = S[eb] * g4;
#pragma unroll
                  for (int ks = 0; ks < 2; ++ks) {
                      const bf16x8 bb = *(const LAS bf16x8*)(VT + (eb * 16 + fr) * 144 + (ks * 32 + fq * 8) * 2);
                      c = __builtin_amdgcn_mfma_f32_16x16x32_bf16(a[ks], bb, c, 0, 0, 0);
                  }
                  S[eb] = c;
              } }
            __syncthreads();
            if (PASS == 1) {
#pragma unroll
                for (int eb = 0; eb < 8; ++eb) { u32x2 v; v.x = pk2(S[eb][0], S[eb][1]); v.y = pk2(S[eb][2], S[eb][3]); *(LAS u32x2*)(ST + (eb * 16 + fr) * 272 + (w * 16 + 4 * fq) * 2) = v; }
            }
        }
        if (PASS == 0) {
            float* Ls = HST + (size_t)(bh * HG_NSEG + seg) * (HD * HD);
#pragma unroll
            for (int eb = 0; eb < 8; ++eb)
#pragma unroll
                for (int jj = 0; jj < 4; ++jj) Ls[(size_t)(w * 16 + 4 * fq + jj) * HD + eb * 16 + fr] = S[eb][jj];
            if (lane == 0) {
#pragma unroll
                for (int i = 0; i < 2; ++i)
#pragma unroll
                    for (int j = 0; j < 8; ++j) HGAM[(size_t)(bh * HG_NSEG + seg) * HD + (w + 8 * i) * 8 + j] = gseg[(w + 8 * i) * 8 + j];
            }
        }
    }
    __syncthreads();
}
__device__ __forceinline__ void phase_ln1(const Params& p, int wg, int G) {
    const int tid = opaque_tid(), w = tid >> 6, lane = tid & 63;
    const bf16_t* r1 = (const bf16_t*)(p.ws + WS_R1); const float* mod = (const float*)(p.ws + WS_MOD);
    unsigned char* h2q = p.ws + WS_H2; float* sh2 = (float*)(p.ws + WS_SH2); float* st = (float*)(p.ws + WS_STAT1);
#pragma unroll 2
    for (int row = wg * 8 + w; row < NT; row += G * 8) {
        const int b = row / SEQ;
        f32x4 v[8]; float s = 0.f;
#pragma unroll
        for (int j = 0; j < 2; ++j)
#pragma unroll
            for (int q = 0; q < 2; ++q) { const u32x4 r = *(const u32x4*)(r1 + (size_t)row * DM + 1024 * j + 16 * lane + 8 * q);
                v[4 * j + 2 * q] = (f32x4){bf_lo(r.x), bf_hi(r.x), bf_lo(r.y), bf_hi(r.y)}; v[4 * j + 2 * q + 1] = (f32x4){bf_lo(r.z), bf_hi(r.z), bf_lo(r.w), bf_hi(r.w)};
                s += ((v[4 * j + 2 * q][0] + v[4 * j + 2 * q][1]) + (v[4 * j + 2 * q][2] + v[4 * j + 2 * q][3])) + ((v[4 * j + 2 * q + 1][0] + v[4 * j + 2 * q + 1][1]) + (v[4 * j + 2 * q + 1][2] + v[4 * j + 2 * q + 1][3])); }
        const float mean = wave_sum(s) * (1.f / DM);
        float s2 = 0.f;
#pragma unroll
        for (int i = 0; i < 8; ++i) { v[i] = v[i] - mean; s2 += (v[i][0] * v[i][0] + v[i][1] * v[i][1]) + (v[i][2] * v[i][2] + v[i][3] * v[i][3]); }
        const float rstd = rsqrtf(wave_sum(s2) * (1.f / DM) + LN_EPS);
        if (lane == 0) { st[row * 2] = mean; st[row * 2 + 1] = rstd; }
        float am = 0.f;
#pragma unroll
        for (int j = 0; j < 2; ++j)
#pragma unroll
            for (int q = 0; q < 4; ++q) {
                const int c = 1024 * j + 16 * lane + 4 * q;
                const f32x4 g = *(const f32x4*)(p.ln1_g + c), bb = *(const f32x4*)(p.ln1_b + c);
                const f32x4 sh = *(const f32x4*)(mod + b * 6 * DM + 3 * DM + c), sc = *(const f32x4*)(mod + b * 6 * DM + 4 * DM + c);
                const f32x4 hh = (v[4 * j + q] * rstd * g + bb) * (1.f + sc) + sh;
                v[4 * j + q] = hh;
                am = fmaxf(am, fmaxf(fmaxf(fabsf(hh[0]), fabsf(hh[1])), fmaxf(fabsf(hh[2]), fabsf(hh[3]))));
            }
        am = wave_max_nonneg(am);
        const float sc_ = am > 0.f ? am * (1.f / 127.f) : 1.f, inv = am > 0.f ? 127.f / am : 0.f;
        if (lane == 0) sh2[row] = sc_;
#pragma unroll
        for (int j = 0; j < 2; ++j) {
            unsigned wd[4];
#pragma unroll
            for (int q = 0; q < 4; ++q) { unsigned x4 = 0;
#pragma unroll
                for (int e = 0; e < 4; ++e) { const int qi = (int)rintf(v[4 * j + q][e] * inv); x4 |= ((unsigned)qi & 0xffu) << (8 * e); }
                wd[q] = x4; }
            *(u32x4*)(h2q + (size_t)row * DM + 1024 * j + 16 * lane) = (u32x4){wd[0], wd[1], wd[2], wd[3]};
        }
    }
}

__device__ __forceinline__ unsigned f2ord(float f) { const unsigned u = __float_as_uint(f); return (u & 0x80000000u) ? ~u : (u | 0x80000000u); }
__device__ __forceinline__ unsigned wave_max_u32(unsigned v) {
#pragma unroll
    for (int o = 1; o < 64; o <<= 1) { const unsigned t = (unsigned)__shfl_xor((int)v, o); v = t > v ? t : v; }
    return v;
}
constexpr int RT_OFF_TBL = 65536, RT_LDS_END = RT_OFF_TBL + 8 * 8192;
__device__ __forceinline__ void ins16(float (&L)[16], float x) {
#pragma unroll
    for (int i = 15; i >= 1; --i) L[i] = __builtin_amdgcn_fmed3f(L[i - 1], L[i], x);
    L[0] = fmaxf(L[0], x);
}
__device__ __forceinline__ void phase_route(const Params& p, LAS unsigned char* lds, int wg, int G, int only_h = -1, int only_tb = 0) {
    const int tid = opaque_tid(), w = __builtin_amdgcn_readfirstlane(tid >> 6), lane = tid & 63, l31 = lane & 31, h2 = lane >> 5;
    const bf16_t* QP = (const bf16_t*)(p.ws + WS_QP); const bf16_t* SK = (const bf16_t*)(p.ws + WS_SKB);
    int* RIDX = (int*)(p.ws + WS_RIDX); float* RGATE = (float*)(p.ws + WS_RGATE); float* RUS = (float*)(p.ws + WS_RUS);
    const float* USC = (const float*)(p.ws + WS_USC); const float* VSC = (const float*)(p.ws + WS_VSC);
    LAS float* tbl = (LAS float*)(lds + RT_OFF_TBL + w * 8192);
    for (int item = (only_h >= 0 ? 0 : wg); item < (only_h >= 0 ? 1 : PH * (NT / 256)); item += G) {
        const int h = only_h >= 0 ? only_h : item / (NT / 256), tb = only_h >= 0 ? only_tb : item % (NT / 256);
        __syncthreads();
#pragma unroll
        for (int i = 0; i < 8; ++i) {
            const int id = tid + i * NTHR, row = id >> 4, c16 = id & 15;
            *(LAS u32x4*)(lds + row * 256 + ((c16 ^ (row & 15)) << 4)) = *(const u32x4*)(SK + ((size_t)h * 256 + row) * 128 + c16 * 8);
        }
        __syncthreads();
        const int t = tb * 256 + w * 32 + l31;
#pragma unroll 1
        for (int pp = 0; pp < 2; ++pp) {
            bf16x8 qf[8];
            { const bf16_t* qrow = QP + (size_t)t * DM + h * 256 + pp * 128 + h2 * 8;
#pragma unroll
              for (int ks = 0; ks < 8; ++ks) qf[ks] = *(const bf16x8*)(qrow + ks * 16); }
            float L[16];
#pragma unroll
            for (int i = 0; i < 16; ++i) L[i] = -INFINITY;
#pragma unroll 1
            for (int nb = 0; nb < 4; ++nb) {
                f32x16 S;
#pragma unroll
                for (int r = 0; r < 16; ++r) S[r] = 0.f;
                const int row = pp * 128 + nb * 32 + l31;
#pragma unroll
                for (int ks = 0; ks < 8; ++ks) {
                    const bf16x8 a = *(const LAS bf16x8*)(lds + row * 256 + (((ks * 2 + h2) ^ (row & 15)) << 4));
                    S = __builtin_amdgcn_mfma_f32_32x32x16_bf16(a, qf[ks], S, 0, 0, 0);
                }
#pragma unroll
                for (int r = 0; r < 16; ++r) {
                    const unsigned n = (unsigned)(nb * 32 + (r & 3) + 8 * (r >> 2) + 4 * h2);
                    ins16(L, __uint_as_float((__float_as_uint(S[r]) & ~127u) | n));
                }
            }
            float P[16];
#pragma unroll
            for (int i = 0; i < 16; ++i) P[i] = __shfl_xor(L[i], 32);
#pragma unroll
            for (int i = 0; i < 16; ++i) ins16(L, P[i]);
#pragma unroll
            for (int i = 0; i < 16; ++i) tbl[(pp * 16 + i) * 64 + lane] = L[i];
        }
        float L0[16], L1[16];
#pragma unroll
        for (int i = 0; i < 16; ++i) { L0[i] = tbl[i * 64 + lane]; L1[i] = tbl[(16 + i) * 64 + lane]; }
        float C[16];
#pragma unroll
        for (int i = 0; i < 16; ++i) C[i] = -INFINITY;
#pragma unroll
        for (int a = 0; a < 16; ++a)
#pragma unroll
            for (int b = 0; b < 16; ++b)
                if ((a + 1) * (b + 1) <= 16) ins16(C, __uint_as_float((__float_as_uint(L0[a] + L1[b]) & ~255u) | (unsigned)(a * 16 + b)));
        const float vmax = C[0];
        float den = 0.f, ex[16];
#pragma unroll
        for (int i = 0; i < 16; ++i) { ex[i] = __expf(C[i] - vmax); den += ex[i]; }
        const float rden = 1.f / den;
        int* ip = RIDX + (size_t)t * 128 + h * 16 + h2 * 8; float* gp = RGATE + (size_t)t * 128 + h * 16 + h2 * 8; float* up = RUS + (size_t)t * 128 + h * 16 + h2 * 8;
        int eo[16]; float go[16], uo[16];
#pragma unroll
        for (int j = 0; j < 16; ++j) {
            const unsigned cb = __float_as_uint(C[j]), a = (cb >> 4) & 15u, b = cb & 15u;
            const unsigned i0 = __float_as_uint(tbl[a * 64 + lane]) & 127u, i1 = __float_as_uint(tbl[(16 + b) * 64 + lane]) & 127u;
            eo[j] = (int)(i0 * NKEYS + i1);
        }
#pragma unroll
        for (int j = 0; j < 16; ++j) { go[j] = ex[j] * rden * VSC[eo[j]]; uo[j] = USC[eo[j]]; }
        if (h2 == 0) {
            *(int4*)ip = make_int4(eo[0], eo[1], eo[2], eo[3]); *(int4*)(ip + 4) = make_int4(eo[4], eo[5], eo[6], eo[7]);
            *(f32x4*)gp = (f32x4){go[0], go[1], go[2], go[3]}; *(f32x4*)(gp + 4) = (f32x4){go[4], go[5], go[6], go[7]};
            *(f32x4*)up = (f32x4){uo[0], uo[1], uo[2], uo[3]}; *(f32x4*)(up + 4) = (f32x4){uo[4], uo[5], uo[6], uo[7]};
        } else {
            *(int4*)ip = make_int4(eo[8], eo[9], eo[10], eo[11]); *(int4*)(ip + 4) = make_int4(eo[12], eo[13], eo[14], eo[15]);
            *(f32x4*)gp = (f32x4){go[8], go[9], go[10], go[11]}; *(f32x4*)(gp + 4) = (f32x4){go[12], go[13], go[14], go[15]};
            *(f32x4*)up = (f32x4){uo[8], uo[9], uo[10], uo[11]}; *(f32x4*)(up + 4) = (f32x4){uo[12], uo[13], uo[14], uo[15]};
        }
    }
    __syncthreads();
}

__device__ __forceinline__ float gelu_exact(float v) { return 0.5f * v * (1.f + erff(v * 0.70710678118654752f)); }
__device__ __forceinline__ float ub0(unsigned w) { return (float)(w & 0xffu); }
__device__ __forceinline__ float ub1(unsigned w) { return (float)((w >> 8) & 0xffu); }
__device__ __forceinline__ float ub2(unsigned w) { return (float)((w >> 16) & 0xffu); }
__device__ __forceinline__ float ub3(unsigned w) { return (float)(w >> 24); }
#if U_FP6
constexpr int PE_OFF_XQ = 0, PE_OFF_KEYS = 131072, PE_OFF_XS = 147456, PE_OFF_WT = 0, PE_OFF_PW = 16384, PE_LDS_END = PE_OFF_XS + 256;
#else
constexpr int PE_OFF_XQ = 0, PE_OFF_KEYS = 65536, PE_OFF_WT = 81920, PE_OFF_PW = 98304, PE_OFF_XS = 114688, PE_LDS_END = PE_OFF_XS + 256;
#endif
constexpr int PE_VB = 16;
__device__ __forceinline__ void peer_axpy(f32x2 (&a)[16], float wgt, const u32x4 (&v)[2]) {
    const f32x2 w2 = {wgt, wgt};
#pragma unroll
    for (int j = 0; j < 2; ++j) {
        const unsigned r[4] = {v[j].x, v[j].y, v[j].z, v[j].w};
#pragma unroll
        for (int q = 0; q < 4; ++q) {
            a[8 * j + 2 * q] += w2 * __builtin_amdgcn_cvt_pk_f32_fp8((int)r[q], false);
            a[8 * j + 2 * q + 1] += w2 * __builtin_amdgcn_cvt_pk_f32_fp8((int)r[q], true);
        }
    }
}
__device__ __forceinline__ void peer_axpy6(f32x2 (&a)[16], float wgt, const u32x4& va, const u32x2& vb) {
    const f32x2 w2 = {wgt, wgt};
    const u32x6v pk = {va.x, va.y, va.z, va.w, vb.x, vb.y};
    const f32x32v y = __builtin_amdgcn_cvt_scalef32_pk32_f32_fp6(pk, 1.0f);
#pragma unroll
    for (int i = 0; i < 16; ++i) a[i] += w2 * (f32x2){y[2 * i], y[2 * i + 1]};
}
__device__ __forceinline__ void peer_axpy4(f32x2 (&a)[16], float wgt, const u32x4& va) {
    const f32x2 w2 = {wgt, wgt};
    const unsigned r[4] = {va.x, va.y, va.z, va.w};
#pragma unroll
    for (int q = 0; q < 4; ++q) {
        a[4 * q + 0] += w2 * __builtin_amdgcn_cvt_scalef32_pk_f32_fp4(r[q], 1.0f, 0);
        a[4 * q + 1] += w2 * __builtin_amdgcn_cvt_scalef32_pk_f32_fp4(r[q], 1.0f, 1);
        a[4 * q + 2] += w2 * __builtin_amdgcn_cvt_scalef32_pk_f32_fp4(r[q], 1.0f, 2);
        a[4 * q + 3] += w2 * __builtin_amdgcn_cvt_scalef32_pk_f32_fp4(r[q], 1.0f, 3);
    }
}
__device__ __forceinline__ void peer_ln2_store(const Params& p, f32x2 (&acc2)[16], int t, int lane_in) {
    int lane = lane_in; asm volatile("" : "+v"(lane));
    const bf16_t* r1 = (const bf16_t*)(p.ws + WS_R1); const float* st = (const float*)(p.ws + WS_STAT1); const float* mod = (const float*)(p.ws + WS_MOD);
    const int b = t / SEQ;
    float acc[32];
#pragma unroll
    for (int i = 0; i < 16; ++i) { acc[2 * i] = acc2[i].x; acc[2 * i + 1] = acc2[i].y; }
    const float mean1 = st[t * 2], rstd1 = st[t * 2 + 1];
    float s = 0.f;
#pragma unroll
    for (int j = 0; j < 2; ++j)
#pragma unroll
        for (int q = 0; q < 4; ++q) {
            const int c = 1024 * j + 16 * lane + 4 * q;
            const u32x2 rb = *(const u32x2*)(r1 + (size_t)t * DM + c); const f32x4 rv = {bf_lo(rb.x), bf_hi(rb.x), bf_lo(rb.y), bf_hi(rb.y)}, g = *(const f32x4*)(p.ln1_g + c), bb = *(const f32x4*)(p.ln1_b + c);
            const f32x4 g2 = *(const f32x4*)(mod + b * 6 * DM + 5 * DM + c);
#pragma unroll
            for (int k = 0; k < 4; ++k) {
                const float x1 = (rv[k] - mean1) * rstd1 * g[k] + bb[k];
                const float val = ALPHA * x1 + (1.f + g2[k]) * acc[16 * j + 4 * q + k];
                acc[16 * j + 4 * q + k] = val; s += val;
            }
            asm volatile("" ::: "memory");
        }
    const float mean = wave_sum(s) * (1.f / DM);
    float s2 = 0.f;
#pragma unroll
    for (int i = 0; i < 32; ++i) { acc[i] -= mean; s2 += acc[i] * acc[i]; }
    const float rstd = rsqrtf(wave_sum(s2) * (1.f / DM) + LN_EPS);
#pragma unroll
    for (int j = 0; j < 2; ++j)
#pragma unroll
        for (int q = 0; q < 4; ++q) {
            const int c = 1024 * j + 16 * lane + 4 * q;
            const f32x4 g = *(const f32x4*)(p.ln2_g + c), bb = *(const f32x4*)(p.ln2_b + c);
            f32x4 o;
#pragma unroll
            for (int k = 0; k < 4; ++k) o[k] = acc[16 * j + 4 * q + k] * rstd * g[k] + bb[k];
            *(f32x4*)(p.out + (size_t)t * DM + c) = o;
            asm volatile("" ::: "memory");
        }
}
__device__ __forceinline__ void phase_peer(const Params& p, LAS unsigned char* lds, int wg, int G) {
    const int tid = opaque_tid(), w = __builtin_amdgcn_readfirstlane(tid >> 6), lane = tid & 63;
    const unsigned char* UQ = p.ws + WS_UQ; const unsigned char* VQ = p.ws + WS_VQ;
    const int* RIDX = (const int*)(p.ws + WS_RIDX); const float* RGATE = (const float*)(p.ws + WS_RGATE); const float* RUS = (const float*)(p.ws + WS_RUS);
    LAS unsigned char* XQ = lds + PE_OFF_XQ; LAS unsigned* KEYS = (LAS unsigned*)(lds + PE_OFF_KEYS); LAS float* WT = (LAS float*)(lds + PE_OFF_WT);
    LAS unsigned* PW = (LAS unsigned*)(lds + PE_OFF_PW) + w * 512; LAS float* XS = (LAS float*)(lds + PE_OFF_XS);
    for (int item = wg; item < NT / 32; item += G) {
        const int t0 = item * 32;
        __syncthreads();
#pragma unroll
        for (int k = 0; k < 4; ++k) {
            const int tl = 4 * w + k;
            const unsigned char* src = (p.ws + WS_H2) + (size_t)(t0 + tl) * DM + 16 * lane;
#if U_FP6
            {
                const u32x4 s0 = *(const u32x4*)src, s1 = *(const u32x4*)(src + 1024);
#pragma unroll
                for (int hlf = 0; hlf < 2; ++hlf) {
                    const u32x4 sv = hlf ? s1 : s0; unsigned o[8];
#pragma unroll
                    for (int q = 0; q < 4; ++q) {
                        const unsigned uw = sv[q] ^ 0x80808080u;
                        const f16x2v lo = {(_Float16)(ub0(uw) - 128.f), (_Float16)(ub1(uw) - 128.f)};
                        const f16x2v hi = {(_Float16)(ub2(uw) - 128.f), (_Float16)(ub3(uw) - 128.f)};
                        o[2 * q] = __builtin_bit_cast(unsigned, lo); o[2 * q + 1] = __builtin_bit_cast(unsigned, hi);
                    }
                    LAS unsigned char* xd = XQ + tl * 4096 + 2048 * hlf + 32 * lane;
                    *(LAS u32x4*)xd = (u32x4){o[0], o[1], o[2], o[3]}; *(LAS u32x4*)(xd + 16) = (u32x4){o[4], o[5], o[6], o[7]};
                }
            }
#else
            *(LAS u32x4*)(XQ + tl * DM + 16 * lane) = *(const u32x4*)src; *(LAS u32x4*)(XQ + tl * DM + 1024 + 16 * lane) = *(const u32x4*)(src + 1024);
#endif
            if (lane == 0) XS[tl] = ((const float*)(p.ws + WS_SH2))[t0 + tl];
        }
#pragma unroll
        for (int k = 0; k < 8; ++k) { const int idx = tid + NTHR * k; KEYS[idx] = ((unsigned)RIDX[(size_t)t0 * 128 + idx] << 12) | (unsigned)idx; }
        __syncthreads();
        for (int k = 2; k <= 4096; k <<= 1)
            for (int j = k >> 1; j > 0; j >>= 1) {
#pragma unroll
                for (int qq = 0; qq < 4; ++qq) {
                    const int q = tid + NTHR * qq, lo = ((q & ~(j - 1)) << 1) | (q & (j - 1)), hi = lo | j;
                    const unsigned a = KEYS[lo], b = KEYS[hi];
                    const bool up = (lo & k) == 0;
                    if ((a > b) == up) { KEYS[lo] = b; KEYS[hi] = a; }
                }
                __syncthreads();
            }
#if U_FP6
        float wreg[8];
#pragma unroll
        for (int j = 0; j < 8; ++j) wreg[j] = 0.f;
#pragma unroll 1
        for (int g = 0; g < 8; ++g) {
            int lane_u = lane; asm volatile("" : "+v"(lane_u));
            const unsigned mykey = KEYS[g * 512 + lane_u * 8 + w];
            const int e_l = (int)(mykey >> 12), ts_l = (int)(mykey & 4095u), tl_l = ts_l >> 7;
            float v0[64];
#pragma unroll
            for (int k = 0; k < 64; ++k) {
                const int ek = __builtin_amdgcn_readlane(e_l, k), tlk = __builtin_amdgcn_readlane(tl_l, k);
                const unsigned char* ur = UQ + (size_t)ek * UROW;
                const u32x4 u0 = *(const u32x4*)(ur + 16 * lane_u); const u32x2 u1 = *(const u32x2*)(ur + 1024 + 8 * lane_u);
                const LAS unsigned char* xr = XQ + tlk * 4096 + 32 * lane_u;
                const u32x4 x0 = *(const LAS u32x4*)xr, x1 = *(const LAS u32x4*)(xr + 16), x2 = *(const LAS u32x4*)(xr + 2048), x3 = *(const LAS u32x4*)(xr + 2048 + 16);
                const u32x6v pk = {u0.x, u0.y, u0.z, u0.w, u1.x, u1.y};
                const f16x32v y = __builtin_amdgcn_cvt_scalef32_pk32_f16_fp6(pk, 1.0f);
                const f16x8v h0 = __builtin_bit_cast(f16x8v, x0), h1 = __builtin_bit_cast(f16x8v, x1), h2 = __builtin_bit_cast(f16x8v, x2), h3 = __builtin_bit_cast(f16x8v, x3);
                float d = 0.f;
#pragma unroll
                for (int i = 0; i < 4; ++i) {
                    d = __builtin_amdgcn_fdot2((f16x2v){y[2 * i], y[2 * i + 1]}, (f16x2v){h0[2 * i], h0[2 * i + 1]}, d, false);
                    d = __builtin_amdgcn_fdot2((f16x2v){y[8 + 2 * i], y[8 + 2 * i + 1]}, (f16x2v){h1[2 * i], h1[2 * i + 1]}, d, false);
                    d = __builtin_amdgcn_fdot2((f16x2v){y[16 + 2 * i], y[16 + 2 * i + 1]}, (f16x2v){h2[2 * i], h2[2 * i + 1]}, d, false);
                    d = __builtin_amdgcn_fdot2((f16x2v){y[24 + 2 * i], y[24 + 2 * i + 1]}, (f16x2v){h3[2 * i], h3[2 * i + 1]}, d, false);
                }
                v0[k] = d;
            }
            float v1[32], v2[16], v3[8], v4[4], v5[2];
            { const bool bt = lane & 1;
#pragma unroll
              for (int i = 0; i < 32; ++i) { const float keep = bt ? v0[2 * i + 1] : v0[2 * i], send = bt ? v0[2 * i] : v0[2 * i + 1]; v1[i] = keep + __shfl_xor(send, 1); } }
            { const bool bt = lane & 2;
#pragma unroll
              for (int i = 0; i < 16; ++i) { const float keep = bt ? v1[2 * i + 1] : v1[2 * i], send = bt ? v1[2 * i] : v1[2 * i + 1]; v2[i] = keep + __shfl_xor(send, 2); } }
            { const bool bt = lane & 4;
#pragma unroll
              for (int i = 0; i < 8; ++i) { const float keep = bt ? v2[2 * i + 1] : v2[2 * i], send = bt ? v2[2 * i] : v2[2 * i + 1]; v3[i] = keep + __shfl_xor(send, 4); } }
            { const bool bt = lane & 8;
#pragma unroll
              for (int i = 0; i < 4; ++i) { const float keep = bt ? v3[2 * i + 1] : v3[2 * i], send = bt ? v3[2 * i] : v3[2 * i + 1]; v4[i] = keep + __shfl_xor(send, 8); } }
            { const bool bt = lane & 16;
#pragma unroll
              for (int i = 0; i < 2; ++i) { const float keep = bt ? v4[2 * i + 1] : v4[2 * i], send = bt ? v4[2 * i] : v4[2 * i + 1]; v5[i] = keep + __shfl_xor(send, 16); } }
            float tot;
            { const bool bt = lane & 32; const float keep = bt ? v5[1] : v5[0], send = bt ? v5[0] : v5[1]; tot = keep + __shfl_xor(send, 32); }
            const size_t eo = (size_t)t0 * 128 + ts_l;
            const float act = RUS[eo] * XS[tl_l] * tot;
            const float wv = RGATE[eo] * gelu_exact(act);
#pragma unroll
            for (int j = 0; j < 8; ++j) wreg[j] = (g == j) ? wv : wreg[j];
        }
        __syncthreads();
#pragma unroll
        for (int j = 0; j < 8; ++j) { const unsigned key = KEYS[j * 512 + lane * 8 + w]; WT[key & 4095u] = wreg[j]; }
        __syncthreads();
#else
#ifndef PEER_REP_U
#define PEER_REP_U 1
#endif
#pragma unroll 1
        for (int g = 0; g < 8 * PEER_REP_U; ++g) {
            int lane_u = lane; asm volatile("" : "+v"(lane_u));
            const unsigned mykey = KEYS[(g & 7) * 512 + lane_u * 8 + w];
            const int e_l = (int)(mykey >> 12), ts_l = (int)(mykey & 4095u), tl_l = ts_l >> 7;
            int v0[64];
#pragma unroll
            for (int k = 0; k < 64; ++k) {
                const int ek = __builtin_amdgcn_readlane(e_l, k), tlk = __builtin_amdgcn_readlane(tl_l, k);
                const unsigned char* ur = UQ + (size_t)ek * DM + 16 * lane_u;
                const u32x4 u0 = *(const u32x4*)ur, u1 = *(const u32x4*)(ur + 1024);
                const LAS unsigned char* xr = XQ + tlk * DM + 16 * lane_u;
                const u32x4 x0 = *(const LAS u32x4*)xr, x1 = *(const LAS u32x4*)(xr + 1024);
                int d = 0;
                d = __builtin_amdgcn_sdot4((int)u0.x, (int)x0.x, d, false); d = __builtin_amdgcn_sdot4((int)u0.y, (int)x0.y, d, false);
                d = __builtin_amdgcn_sdot4((int)u0.z, (int)x0.z, d, false); d = __builtin_amdgcn_sdot4((int)u0.w, (int)x0.w, d, false);
                d = __builtin_amdgcn_sdot4((int)u1.x, (int)x1.x, d, false); d = __builtin_amdgcn_sdot4((int)u1.y, (int)x1.y, d, false);
                d = __builtin_amdgcn_sdot4((int)u1.z, (int)x1.z, d, false); d = __builtin_amdgcn_sdot4((int)u1.w, (int)x1.w, d, false);
                v0[k] = d;
            }
            int v1[32], v2[16], v3[8], v4[4], v5[2];
            { const bool bt = lane & 1;
#pragma unroll
              for (int i = 0; i < 32; ++i) { const int keep = bt ? v0[2 * i + 1] : v0[2 * i], send = bt ? v0[2 * i] : v0[2 * i + 1]; v1[i] = keep + __shfl_xor(send, 1); } }
            { const bool bt = lane & 2;
#pragma unroll
              for (int i = 0; i < 16; ++i) { const int keep = bt ? v1[2 * i + 1] : v1[2 * i], send = bt ? v1[2 * i] : v1[2 * i + 1]; v2[i] = keep + __shfl_xor(send, 2); } }
            { const bool bt = lane & 4;
#pragma unroll
              for (int i = 0; i < 8; ++i) { const int keep = bt ? v2[2 * i + 1] : v2[2 * i], send = bt ? v2[2 * i] : v2[2 * i + 1]; v3[i] = keep + __shfl_xor(send, 4); } }
            { const bool bt = lane & 8;
#pragma unroll
              for (int i = 0; i < 4; ++i) { const int keep = bt ? v3[2 * i + 1] : v3[2 * i], send = bt ? v3[2 * i] : v3[2 * i + 1]; v4[i] = keep + __shfl_xor(send, 8); } }
            { const bool bt = lane & 16;
#pragma unroll
              for (int i = 0; i < 2; ++i) { const int keep = bt ? v4[2 * i + 1] : v4[2 * i], send = bt ? v4[2 * i] : v4[2 * i + 1]; v5[i] = keep + __shfl_xor(send, 16); } }
            int tot;
            { const bool bt = lane & 32; const int keep = bt ? v5[1] : v5[0], send = bt ? v5[0] : v5[1]; tot = keep + __shfl_xor(send, 32); }
            const size_t eo = (size_t)t0 * 128 + ts_l;
            const float act = RUS[eo] * XS[tl_l] * (float)tot;
            WT[ts_l] = RGATE[eo] * gelu_exact(act);
        }
        __syncthreads();
#endif
        { int base0 = 0, base1 = 256;
#pragma unroll 1
          for (int c = 0; c < 64; ++c) {
              const unsigned key = KEYS[c * 64 + lane];
              const bool mine = ((key >> 9) & 7u) == (unsigned)w, hi = (key >> 8) & 1u;
              const unsigned long long m0 = __ballot(mine && !hi), m1 = __ballot(mine && hi), lt = (1ull << lane) - 1ull;
              if (mine && !hi) PW[base0 + __popcll(m0 & lt)] = key;
              if (mine && hi) PW[base1 + __popcll(m1 & lt)] = key;
              base0 += __popcll(m0); base1 += __popcll(m1);
          } }
#ifndef PEER_REP_V
#define PEER_REP_V 1
#endif
#pragma unroll 1
        for (int half_ = 0; half_ < 2 * PEER_REP_V; ++half_) {
            const int half = half_ & 1;
            int lane_v = lane; asm volatile("" : "+v"(lane_v));
            f32x2 a0[16], a1[16];
#pragma unroll
            for (int i = 0; i < 16; ++i) { a0[i] = (f32x2){0.f, 0.f}; a1[i] = (f32x2){0.f, 0.f}; }
#pragma unroll 1
            for (int i0 = 0; i0 < 256; i0 += PE_VB) {
                u32x4 vv[PE_VB][2]; float wg_[PE_VB]; int sel[PE_VB];
#pragma unroll
                for (int q = 0; q < PE_VB; ++q) {
                    const unsigned key = (unsigned)__builtin_amdgcn_readfirstlane((int)PW[half * 256 + i0 + q]);
#ifdef PEER_VPROBE
                    const unsigned char* vr = VQ + (size_t)((half_ >= 2) ? ((key >> 12) & 511u) : (key >> 12)) * DM + 16 * lane_v;
#else
                    const unsigned char* vr = VQ + (size_t)(key >> 12) * VROW + 16 * lane_v;
#endif
#if V_FP4
                    vv[q][0] = *(const u32x4*)vr; vv[q][1] = (u32x4){0u, 0u, 0u, 0u};
#elif V_FP6
                    vv[q][0] = *(const u32x4*)vr; { const u32x2 t2 = *(const u32x2*)(vr + 1024 - 8 * lane_v); vv[q][1] = (u32x4){t2.x, t2.y, 0u, 0u}; }
#else
                    vv[q][0] = *(const u32x4*)vr; vv[q][1] = *(const u32x4*)(vr + 1024);
#endif
                    wg_[q] = __int_as_float(__builtin_amdgcn_readfirstlane(__float_as_int(WT[key & 4095u]))); sel[q] = (int)((key >> 7) & 1u);
                }
#pragma unroll
                for (int q = 0; q < PE_VB; ++q) {
#if V_FP4
                    if (sel[q] == 0) peer_axpy4(a0, wg_[q], vv[q][0]);
                    else peer_axpy4(a1, wg_[q], vv[q][0]);
#elif V_FP6
                    if (sel[q] == 0) peer_axpy6(a0, wg_[q], vv[q][0], (u32x2){vv[q][1].x, vv[q][1].y});
                    else peer_axpy6(a1, wg_[q], vv[q][0], (u32x2){vv[q][1].x, vv[q][1].y});
#else
                    if (sel[q] == 0) peer_axpy(a0, wg_[q], vv[q]);
                    else peer_axpy(a1, wg_[q], vv[q]);
#endif
                }
            }
#ifdef PEER_VPROBE
            if (half_ >= 2) { asm volatile("" :: "v"(a0[0].x + a1[3].y)); continue; }
#endif
            peer_ln2_store(p, a0, t0 + 4 * w + 2 * half + 0, lane_v);
            peer_ln2_store(p, a1, t0 + 4 * w + 2 * half + 1, lane_v);
        }
    }
    __syncthreads();
}
constexpr int LDS_BAR_OFF = 153600, LDS_BYTES = LDS_BAR_OFF + 64;
static_assert(HG_LDS_END <= LDS_BAR_OFF && PE_LDS_END <= LDS_BAR_OFF && RT_LDS_END <= LDS_BAR_OFF && pg8::STAGE_BYTES <= LDS_BAR_OFF, "LDS map");
constexpr int N_PHASES = 11;
extern __shared__ __attribute__((aligned(16))) unsigned char smem_raw[];

template <int PH>
__device__ __forceinline__ void run_phase(const Params& p, LAS unsigned char* lds, int wg, int G) {
    if constexpr (PH == 0) { phase_ada(p, lds, wg, G); phase_conv(p, lds, wg, G); }
    if constexpr (PH == 1) { phase_hmod(p, wg, G); }
    if constexpr (PH == 2) { pg8::StaticOrder S; S.init(NT, DIN, G, wg); pg8::Gemm g{(const bf16_t*)(p.ws + WS_HBF), (const bf16_t*)(p.ws + WS_WQ8), NT, DIN, DM / 2}; EpiProj E{p.ws};
        const int rem = S.nwg % G; const bool shortwg = rem != 0 && wg >= rem, first = shortwg;
        if (first) phase_vtab(p, wg - rem, G - rem);
        pg8::gemm_phase(lds, g, S, E);
        if (rem == 0) phase_vtab(p, wg, G); else if (shortwg && !first) phase_vtab(p, wg - rem, G - rem); }
    if constexpr (PH == 3) { phase_hgrn<0>(p, lds, wg, G); }
    if constexpr (PH == 4) { phase_attn(p, lds, wg, G); phase_hgrn<1>(p, lds, wg, G); }
    if constexpr (PH == 5) { pg8::StaticOrder S; S.init(NT, DM, G, wg); pg8::Gemm g{(const bf16_t*)(p.ws + WS_AB), (const bf16_t*)(p.ws + WS_WAT), NT, DM, DM}; EpiMerge2 E{p.ws}; pg8::gemm_phase(lds, g, S, E); }
    if constexpr (PH == 6) { pg8::StaticOrder S; S.init(NT, DM, G, wg); pg8::Gemm g{(const bf16_t*)(p.ws + WS_MERGED), (const bf16_t*)(p.ws + WS_WOT), NT, DM, DM}; EpiRes1 E{p.ws, p.x}; pg8::gemm_phase(lds, g, S, E); }
    if constexpr (PH == 7) { phase_ln1(p, wg, G); }
    if constexpr (PH == 8) { pg8::StaticOrder S; S.init(NT, DM, G, wg); pg8::Gemm g{(const bf16_t*)(p.ws + WS_H2), (const bf16_t*)(p.ws + WS_WQ8B), NT, DM, DM / 2}; EpiQP8 E{p.ws}; pg8::gemm_phase(lds, g, S, E);
        asm volatile("s_waitcnt vmcnt(0)" ::: "memory"); __syncthreads();
        pg8::Unit u; for (int i = 0; S.next(i, u); ++i) phase_route(p, lds, wg, G, u.pn, u.pm); }
    if constexpr (PH == 9) { }
    if constexpr (PH == 10) { phase_peer(p, lds, wg, G); }
}

struct KArgs { Params p; int ph_lo, ph_hi; };

__global__ void __launch_bounds__(NTHR, 2) k_fwd(KArgs a) {
    LAS unsigned char* lds = (LAS unsigned char*)smem_raw;
    const int wg = blockIdx.x, G = gridDim.x;
    volatile LAS unsigned* st = (volatile LAS unsigned*)(lds + LDS_BAR_OFF);
    XcdBarrier xb; xb.bar = (unsigned*)(a.p.ws + WS_BAR); xb.x = 0; xb.st = st;
    if (a.ph_hi - a.ph_lo > 1) {
        if (threadIdx.x == 0) { st[0] = 0; st[1] = 0; st[2] = 0; st[3] = 0; }
        __syncthreads();
        xb = xcd_barrier_post((unsigned*)(a.p.ws + WS_BAR), st);
    }
#ifndef DOUBLE_MASK
#define DOUBLE_MASK 0
#endif
#define OPAQUE_WS(Q) { unsigned long long u_ = (unsigned long long)(Q).ws; asm volatile("" : "+s"(u_)); (Q).ws = (unsigned char*)(__attribute__((address_space(1))) unsigned char*)u_; }
#define RUN_PHASE(PH) if (a.ph_lo <= PH && PH < a.ph_hi) { Params q = a.p; OPAQUE_WS(q); run_phase<PH>(q, lds, wg, G); \
        if ((DOUBLE_MASK >> PH) & 1) { xcd_barrier(xb); OPAQUE_WS(q); run_phase<PH>(q, lds, wg, G); } \
        if (PH + 1 < a.ph_hi) xcd_barrier(xb); }
    RUN_PHASE(0) RUN_PHASE(1) RUN_PHASE(2)
#if (DOUBLE_MASK & 0x18) == 0
    if (a.ph_lo <= 3 && 4 < a.ph_hi) {
        { Params q = a.p; OPAQUE_WS(q); run_phase<3>(q, lds, wg, G); }
        xcd_barrier_arrive(xb);
        { Params q = a.p; OPAQUE_WS(q); phase_attn(q, lds, wg, G); }
        xcd_barrier_wait(xb);
        { Params q = a.p; OPAQUE_WS(q); phase_hgrn<1>(q, lds, wg, G); }
        if (5 < a.ph_hi) xcd_barrier(xb);
    } else { RUN_PHASE(3) RUN_PHASE(4) }
#else
    RUN_PHASE(3) RUN_PHASE(4)
#endif
    RUN_PHASE(5) RUN_PHASE(6) RUN_PHASE(7) RUN_PHASE(8) RUN_PHASE(10)
#undef RUN_PHASE
}

#ifndef N_LAUNCH_MODE
#define N_LAUNCH_MODE 1
#endif

extern "C" void kernel_launch(void* const* d_in, const int* in_sizes, int n_in, void* d_out, int out_size, void* d_ws, size_t ws_size, hipStream_t stream) {
    static int grid = 0;
    if (grid == 0) {
        if (n_in != 18 || out_size != NT * DM || ws_size < WS_END) { fprintf(stderr, "kernel_launch: unexpected shapes (n_in %d out %d ws %zu need %zu)\n", n_in, out_size, ws_size, (size_t)WS_END); grid = -1; return; }
        int dev = 0, cus = 0;
        if (hipGetDevice(&dev) != hipSuccess || hipDeviceGetAttribute(&cus, hipDeviceAttributeMultiprocessorCount, dev) != hipSuccess) { grid = -1; return; }
        if (hipFuncSetAttribute((const void*)k_fwd, hipFuncAttributeMaxDynamicSharedMemorySize, LDS_BYTES) != hipSuccess) { fprintf(stderr, "kernel_launch: hipFuncSetAttribute failed\n"); grid = -1; return; }
        grid = cus;
    }
    if (grid < 0) return;
    (void)hipMemsetAsync((char*)d_ws + WS_BAR, 0, XCD_BAR_WORDS * 4, stream);
    KArgs a{};
    const float** pp = (const float**)&a.p;
    for (int i = 0; i < 18; ++i) pp[i] = (const float*)d_in[i];
    a.p.out = (float*)d_out; a.p.ws = (unsigned char*)d_ws;
#if N_LAUNCH_MODE == 1
    a.ph_lo = 0; a.ph_hi = N_PHASES;
    hipLaunchKernelGGL(k_fwd, dim3(grid), dim3(NTHR), LDS_BYTES, stream, a);
#else
    for (int ph = 0; ph < N_PHASES; ++ph) { a.ph_lo = ph; a.ph_hi = ph + 1; hipLaunchKernelGGL(k_fwd, dim3(grid), dim3(NTHR), LDS_BYTES, stream, a); }
#endif
}
```

```cpp
#include <hip/hip_runtime.h>
#include <cstdio>
#include <cstdint>

#define LAS __attribute__((address_space(3)))
typedef unsigned short bf16_t;
typedef short bf16x8 __attribute__((ext_vector_type(8)));
typedef float f32x4 __attribute__((ext_vector_type(4)));
typedef float f32x2 __attribute__((ext_vector_type(2)));
typedef float f32x16 __attribute__((ext_vector_type(16)));
typedef unsigned u32x4 __attribute__((ext_vector_type(4)));
typedef int i32x4 __attribute__((ext_vector_type(4)));
typedef unsigned u32x2 __attribute__((ext_vector_type(2)));

constexpr int NB = 2, SEQ = 4096, DM = 2048, NT = NB * SEQ, DIN = 11264;
constexpr int NH = 8, HD = 128, HW = 1024;
constexpr int NEXP = 16384, NKEYS = 128, TOPK = 16, PH = 8;
constexpr float ALPHA = 1.189207115002721f;
constexpr float LN_EPS = 1e-5f, RMS_EPS = 1e-6f;
constexpr float LOG2E = 1.4426950408889634f;
constexpr int NTHR = 512;

constexpr size_t MB = 1024 * 1024;
constexpr size_t WS_BAR   = 0;
constexpr size_t WS_MOD   = 64 * 1024;
constexpr size_t WS_LB    = WS_MOD + 128 * 1024;
constexpr size_t WS_STAT1 = WS_LB + 4096;
constexpr size_t WS_HGAM  = WS_STAT1 + 65536;
constexpr size_t WS_RIDX  = 1 * MB;
constexpr size_t WS_RGATE = WS_RIDX + 4 * MB;
constexpr size_t WS_HST   = WS_RGATE + 4 * MB;
constexpr size_t WS_WINT  = WS_HST + 16 * MB;
constexpr size_t WS_WAT   = WS_WINT + 44 * MB;
constexpr size_t WS_WBT   = WS_WAT + 4 * MB;
constexpr size_t WS_WOT   = WS_WBT + 4 * MB;
constexpr size_t WS_WQT   = WS_WOT + 8 * MB;
constexpr size_t WS_SKB   = WS_WQT + 8 * MB;
constexpr size_t WS_UQ    = WS_SKB + 1 * MB;
constexpr size_t WS_VQ    = WS_UQ + 32 * MB;
constexpr size_t WS_USC   = WS_VQ + 32 * MB;
constexpr size_t WS_VSC   = WS_USC + 64 * 1024;
constexpr size_t WS_SH    = WS_USC + 128 * 1024;
constexpr size_t WS_SW    = WS_SH + 64 * 1024;
constexpr size_t WS_SH2   = WS_SH + 32 * 1024;
constexpr size_t WS_SWQ   = WS_SH + 112 * 1024;
constexpr size_t WS_RUS   = WS_USC + 1 * MB;
constexpr size_t WS_WQ8   = WS_USC + 8 * MB;
constexpr size_t WS_WQ8B  = WS_WQ8 + 24 * MB;
constexpr size_t WS_VBF   = WS_UQ + 64 * MB;
constexpr size_t WS_HBF   = WS_VBF + 64 * MB;
constexpr size_t WS_AB    = WS_HBF;
constexpr size_t WS_PROJ  = WS_HBF + 32 * MB;
constexpr size_t WS_Q     = WS_PROJ;
constexpr size_t WS_K     = WS_Q + 16 * MB;
constexpr size_t WS_VT    = WS_K + 16 * MB;
constexpr size_t WS_HQ    = WS_VT + 16 * MB;
constexpr size_t WS_HF    = WS_HQ + 16 * MB;
constexpr size_t WS_HI    = WS_HF + 16 * MB;
constexpr size_t WS_HG    = WS_HI + 16 * MB;
constexpr size_t WS_GA    = WS_HG + 16 * MB;
constexpr size_t WS_GB    = WS_GA + 32 * MB;
constexpr size_t WS_END   = WS_GB + 32 * MB;
constexpr size_t WS_MERGED = WS_Q;
constexpr size_t WS_R1     = WS_VT;
constexpr size_t WS_H2     = WS_GA;
constexpr size_t WS_QP     = WS_GB;

struct Params {
    const float *x, *c, *w_ada, *b_ada, *w_in, *lb_logits, *hg_norm_g, *w_a, *w_b, *w_out, *ln1_g, *ln1_b, *peer_wq, *subkeys, *peer_u, *peer_v, *ln2_g, *ln2_b;
    float* out;
    unsigned char* ws;
};

__device__ __forceinline__ int opaque_tid() { int t = threadIdx.x; asm volatile("" : "+v"(t)); return t; }
typedef __bf16 bf16x2_t __attribute__((ext_vector_type(2)));
__device__ __forceinline__ unsigned pk2(float lo, float hi) { const bf16x2_t v = __builtin_convertvector((f32x2){lo, hi}, bf16x2_t); return __builtin_bit_cast(unsigned, v); }
__device__ __forceinline__ float bf_lo(unsigned u) { return __uint_as_float(u << 16); }
__device__ __forceinline__ float bf_hi(unsigned u) { return __uint_as_float(u & 0xffff0000u); }
__device__ __forceinline__ float bf2f(bf16_t b) { return __uint_as_float(((unsigned)b) << 16); }
__device__ __forceinline__ bf16_t f2bf(float f) { return (bf16_t)(pk2(f, 0.f) & 0xffffu); }
__device__ __forceinline__ float fast_exp2(float x) { return __builtin_amdgcn_exp2f(x); }
__device__ __forceinline__ float fast_log2(float x) { return __builtin_amdgcn_logf(x); }
__device__ __forceinline__ float fast_rcp(float x) { return __builtin_amdgcn_rcpf(x); }
__device__ __forceinline__ float sigmoidf_(float v) { return fast_rcp(1.f + fast_exp2(-v * LOG2E)); }
__device__ __forceinline__ float siluf_(float v) { return v * sigmoidf_(v); }
__device__ __forceinline__ float wave_sum(float v) {
    v += __int_as_float(__builtin_amdgcn_update_dpp(0, __float_as_int(v), 0x111, 0xf, 0xf, false));
    v += __int_as_float(__builtin_amdgcn_update_dpp(0, __float_as_int(v), 0x112, 0xf, 0xf, false));
    v += __int_as_float(__builtin_amdgcn_update_dpp(0, __float_as_int(v), 0x114, 0xf, 0xf, false));
    v += __int_as_float(__builtin_amdgcn_update_dpp(0, __float_as_int(v), 0x118, 0xf, 0xf, false));
    const float t0 = __int_as_float(__builtin_amdgcn_readlane(__float_as_int(v), 15)), t1 = __int_as_float(__builtin_amdgcn_readlane(__float_as_int(v), 31)),
                t2 = __int_as_float(__builtin_amdgcn_readlane(__float_as_int(v), 47)), t3 = __int_as_float(__builtin_amdgcn_readlane(__float_as_int(v), 63));
    return (t0 + t1) + (t2 + t3);
}
__device__ __forceinline__ float wave_max_nonneg(float v) {
    v = fmaxf(v, __int_as_float(__builtin_amdgcn_update_dpp(0, __float_as_int(v), 0x111, 0xf, 0xf, false)));
    v = fmaxf(v, __int_as_float(__builtin_amdgcn_update_dpp(0, __float_as_int(v), 0x112, 0xf, 0xf, false)));
    v = fmaxf(v, __int_as_float(__builtin_amdgcn_update_dpp(0, __float_as_int(v), 0x114, 0xf, 0xf, false)));
    v = fmaxf(v, __int_as_float(__builtin_amdgcn_update_dpp(0, __float_as_int(v), 0x118, 0xf, 0xf, false)));
    const float t0 = __int_as_float(__builtin_amdgcn_readlane(__float_as_int(v), 15)), t1 = __int_as_float(__builtin_amdgcn_readlane(__float_as_int(v), 31)),
                t2 = __int_as_float(__builtin_amdgcn_readlane(__float_as_int(v), 47)), t3 = __int_as_float(__builtin_amdgcn_readlane(__float_as_int(v), 63));
    return fmaxf(fmaxf(t0, t1), fmaxf(t2, t3));
}

#define XB_TMO      128
#define XB_XCNT(j)  (256  + 64 * (j))
#define XB_XSUB(j)  (1280 + 64 * (j))
#define XB_XGEN(j)  (2304 + 64 * (j))
#define XB_TOP      3328
#define XB_TOPGEN   3392
#define XCD_BAR_WORDS 3456
#define XB_SPIN_CAP (1u << 22)
__device__ __forceinline__ unsigned xb_ld(unsigned* p)              { return __hip_atomic_load(p, __ATOMIC_RELAXED, __HIP_MEMORY_SCOPE_AGENT); }
__device__ __forceinline__ unsigned xb_add(unsigned* p, unsigned v) { return __hip_atomic_fetch_add(p, v, __ATOMIC_RELAXED, __HIP_MEMORY_SCOPE_AGENT); }
__device__ __forceinline__ unsigned xb_xcc_id() { return (unsigned)__builtin_amdgcn_s_getreg((3 << 11) | 20) & 0xFu; }
#define XB_SPIN(cond, bar) do { unsigned _sp = 0; while (cond) { __builtin_amdgcn_s_sleep(1); \
    if ((++_sp & 255u) == 0u) { if (xb_ld(&(bar)[XB_TMO])) break; if (_sp > XB_SPIN_CAP) { atomicAdd(&(bar)[XB_TMO], 1u); break; } } } } while (0)
struct XcdBarrier { unsigned* bar; unsigned x; volatile LAS unsigned* st; };
__device__ __forceinline__ XcdBarrier xcd_barrier_post(unsigned* bar, volatile LAS unsigned* st) {
    XcdBarrier b; b.bar = bar; b.x = xb_xcc_id(); b.st = st;
    if (threadIdx.x == 0) (void)xb_add(&bar[XB_XCNT(b.x)], 1u);
    return b;
}
__device__ __forceinline__ void xcd_barrier_complete(unsigned* bar, unsigned x, unsigned& nloc, unsigned& nx) {
    const unsigned G = gridDim.x * gridDim.y * gridDim.z;
    unsigned sum, cnt, mine, sp = 0u;
    for (;;) {
        sum = 0u; cnt = 0u; mine = 0u;
#pragma unroll
        for (unsigned j = 0; j < 16; ++j) { const unsigned c = xb_ld(&bar[XB_XCNT(j)]); sum += c; cnt += (c > 0u) ? 1u : 0u; mine = (j == x) ? c : mine; }
        if (sum == G) break;
        __builtin_amdgcn_s_sleep(1);
        if ((++sp & 255u) == 0u) { if (xb_ld(&bar[XB_TMO])) break; if (sp > XB_SPIN_CAP) { atomicAdd(&bar[XB_TMO], 1u); break; } }
    }
    nloc = mine > 0u ? mine : 1u; nx = cnt > 0u ? cnt : 1u;
}
__device__ __forceinline__ void xcd_barrier(const XcdBarrier& b) {
    asm volatile("s_waitcnt vmcnt(0)" ::: "memory");
    __syncthreads();
    if (threadIdx.x == 0) {
        unsigned* bar = b.bar;
        __builtin_amdgcn_s_waitcnt(0);
        asm volatile("buffer_inv sc1" ::: "memory");
        unsigned nloc = b.st[0], nx = b.st[1];
        if (nloc == 0u) { xcd_barrier_complete(bar, b.x, nloc, nx); b.st[0] = nloc; b.st[1] = nx; }
        const unsigned old = xb_add(&bar[XB_XSUB(b.x)], 1u);
        const unsigned gen = old / nloc;
        if (old + 1u == (gen + 1u) * nloc) {
            __builtin_amdgcn_fence(__ATOMIC_RELEASE, "agent");
            asm volatile("s_waitcnt vmcnt(0)" ::: "memory");
            const unsigned og = xb_add(&bar[XB_TOP], 1u);
            const unsigned tg = og / nx;
            if (og + 1u == (tg + 1u) * nx) xb_add(&bar[XB_TOPGEN], 1u);
            else XB_SPIN(xb_ld(&bar[XB_TOPGEN]) == tg, bar);
            xb_add(&bar[XB_XGEN(b.x)], 1u);
            asm volatile("s_waitcnt vmcnt(0)" ::: "memory");
        } else {
            if (old - gen * nloc == (3u * nloc) / 4u) asm volatile("buffer_wbl2 sc1" ::: "memory");
            XB_SPIN((int)(xb_ld(&bar[XB_XGEN(b.x)]) - gen) <= 0, bar);
            asm volatile("s_waitcnt vmcnt(0)" ::: "memory");
        }
    }
    __syncthreads();
}

__device__ __forceinline__ void xcd_barrier_arrive(const XcdBarrier& b) {
    asm volatile("s_waitcnt vmcnt(0)" ::: "memory");
    __syncthreads();
    if (threadIdx.x == 0) {
        unsigned* bar = b.bar;
        __builtin_amdgcn_s_waitcnt(0);
        unsigned nloc = b.st[0], nx = b.st[1];
        if (nloc == 0u) { xcd_barrier_complete(bar, b.x, nloc, nx); b.st[0] = nloc; b.st[1] = nx; }
        const unsigned old = xb_add(&bar[XB_XSUB(b.x)], 1u);
        const unsigned gen = old / nloc;
        const unsigned leader = (old + 1u == (gen + 1u) * nloc) ? 1u : 0u;
        if (leader) {
            __builtin_amdgcn_fence(__ATOMIC_RELEASE, "agent");
            asm volatile("s_waitcnt vmcnt(0)" ::: "memory");
            const unsigned og = xb_add(&bar[XB_TOP], 1u);
            const unsigned tg = og / nx;
            if (og + 1u == (tg + 1u) * nx) xb_add(&bar[XB_TOPGEN], 1u);
        }
        b.st[2] = gen; b.st[3] = leader;
    }
}
__device__ __forceinline__ void xcd_barrier_wait(const XcdBarrier& b) {
    asm volatile("s_waitcnt vmcnt(0)" ::: "memory");
    __syncthreads();
    if (threadIdx.x == 0) {
        unsigned* bar = b.bar;
        const unsigned gen = b.st[2], leader = b.st[3];
        XB_SPIN((int)(xb_ld(&bar[XB_TOPGEN]) - gen) <= 0, bar);
        __builtin_amdgcn_fence(__ATOMIC_ACQUIRE, "agent");
        if (leader) xb_add(&bar[XB_XGEN(b.x)], 1u);
        asm volatile("s_waitcnt vmcnt(0)" ::: "memory");
    }
    __syncthreads();
}

__device__ __forceinline__ void phase_ada(const Params& p, LAS unsigned char* lds, int wg, int G) {
    LAS float* cond = (LAS float*)lds;
    LAS float* red = cond + 4096;
    const int tid = opaque_tid(), w = tid >> 6, lane = tid & 63;
    float* mod = (float*)(p.ws + WS_MOD);
    for (int i = tid; i < 2 * DM; i += NTHR) { const float v = p.c[i]; cond[i] = v / (1.f + __expf(-v)); }
    __syncthreads();
    const int r5 = lane / 12, c4 = lane % 12; const bool act = lane < 60;
    for (int item = wg; item < 256; item += G) {
        const int n0 = item * 48;
        f32x4 a0 = {0.f, 0.f, 0.f, 0.f}, a1 = {0.f, 0.f, 0.f, 0.f};
        if (act) {
#pragma unroll 16
            for (int k = w * 5 + r5; k < DM; k += 40) {
                const f32x4 wv = *(const f32x4*)(p.w_ada + (size_t)k * (6 * DM) + n0 + c4 * 4);
                const float c0 = cond[k], c1 = cond[DM + k];
                a0 += c0 * wv; a1 += c1 * wv;
            }
            LAS float* r = red + ((w * 5 + r5) * 12 + c4) * 8;
            *(LAS f32x4*)r = a0; *(LAS f32x4*)(r + 4) = a1;
        }
        __syncthreads();
        if (tid < 96) {
            const int b = tid / 48, n = tid % 48, cc = n >> 2, j = n & 3;
            float s = 0.f;
            for (int g = 0; g < 40; ++g) s += red[(g * 12 + cc) * 8 + b * 4 + j];
            mod[b * (6 * DM) + n0 + n] = s + p.b_ada[n0 + n];
        }
        __syncthreads();
    }
}

__device__ __forceinline__ void transpose_tile(const float* W, int K, int N, bf16_t* WT, int k0, int n0, LAS float* scr, int tid, int ldk = 0, int koff = 0) {
    if (ldk == 0) ldk = K;
#pragma unroll
    for (int i = 0; i < 2; ++i) {
        const int idx = tid + i * NTHR, r = idx >> 4, cq = idx & 15;
        const f32x4 v = *(const f32x4*)(W + (size_t)(k0 + r) * N + n0 + cq * 4);
        LAS float* d = scr + r * 65 + cq * 4;
        d[0] = v[0]; d[1] = v[1]; d[2] = v[2]; d[3] = v[3];
    }
    __syncthreads();
    {
        const int n = tid >> 3, kc = tid & 7;
        const LAS float* s = scr + (kc * 8) * 65 + n;
        u32x4 o; o.x = pk2(s[0], s[65]); o.y = pk2(s[2 * 65], s[3 * 65]); o.z = pk2(s[4 * 65], s[5 * 65]); o.w = pk2(s[6 * 65], s[7 * 65]);
        *(u32x4*)(WT + (size_t)(n0 + n) * ldk + koff + k0 + kc * 8) = o;
    }
    __syncthreads();
}
__device__ __forceinline__ void convert_chunk(const float* src, bf16_t* dst, size_t e0, int tid) {
    const f32x4 a = *(const f32x4*)(src + e0 + (size_t)tid * 8), b = *(const f32x4*)(src + e0 + (size_t)tid * 8 + 4);
    u32x4 o; o.x = pk2(a[0], a[1]); o.y = pk2(a[2], a[3]); o.z = pk2(b[0], b[1]); o.w = pk2(b[2], b[3]);
    *(u32x4*)(dst + e0 + (size_t)tid * 8) = o;
}
template <int OFFS>
__device__ __forceinline__ void quantize_row(const float* src, unsigned char* dst, float* scales, int row, int lane) {
    const float* s = src + (size_t)row * DM;
    f32x4 v[8]; float am = 0.f;
#pragma unroll
    for (int j = 0; j < 2; ++j)
#pragma unroll
        for (int q = 0; q < 4; ++q) { v[4 * j + q] = *(const f32x4*)(s + 1024 * j + 16 * lane + 4 * q);
            am = fmaxf(am, fmaxf(fmaxf(fabsf(v[4 * j + q][0]), fabsf(v[4 * j + q][1])), fmaxf(fabsf(v[4 * j + q][2]), fabsf(v[4 * j + q][3])))); }
    am = wave_max_nonneg(am);
    const float sc = am > 0.f ? am * (1.f / 127.f) : 1.f, inv = am > 0.f ? 127.f / am : 0.f;
    if (lane == 0) scales[row] = sc;
#pragma unroll
    for (int j = 0; j < 2; ++j) {
        unsigned wds[4];
#pragma unroll
        for (int q = 0; q < 4; ++q) {
            unsigned wd = 0;
#pragma unroll
            for (int k = 0; k < 4; ++k) { int qi = (int)rintf(v[4 * j + q][k] * inv); qi = qi < -127 ? -127 : (qi > 127 ? 127 : qi); wd |= ((unsigned)(qi + OFFS) & 0xffu) << (8 * k); }
            wds[q] = wd;
        }
        *(u32x4*)(dst + (size_t)row * DM + 1024 * j + 16 * lane) = (u32x4){wds[0], wds[1], wds[2], wds[3]};
    }
}
#ifndef V_FP6
#define V_FP6 1
#endif
#ifndef U_FP6
#define U_FP6 0
#endif
#ifndef V_FP4
#define V_FP4 1
#endif
constexpr int VROW = V_FP4 ? 1024 : (V_FP6 ? 1536 : 2048);
constexpr int UROW = U_FP6 ? 1536 : 2048;
typedef float f32x16v __attribute__((ext_vector_type(16)));
typedef float f32x32v __attribute__((ext_vector_type(32)));
typedef unsigned u32x6v __attribute__((ext_vector_type(6)));
typedef _Float16 f16x2v __attribute__((ext_vector_type(2)));
typedef _Float16 f16x8v __attribute__((ext_vector_type(8)));
typedef _Float16 f16x32v __attribute__((ext_vector_type(32)));
__device__ __forceinline__ u32x6v pack_fp6_2x16(const f32x16v& a, const f32x16v& b) {
    u32x6v r;
    asm volatile("v_cvt_scalef32_2xpk16_fp6_f32 %0, %1, %2, 1.0" : "=&v"(r) : "v"(a), "v"(b));
    return r;
}
__device__ __forceinline__ void utab_load(const Params& p, int row, int lane, f32x4 (&v)[8]) {
    const float* s = p.peer_u + (size_t)row * DM;
#pragma unroll
    for (int j = 0; j < 2; ++j)
#pragma unroll
        for (int q = 0; q < 4; ++q) v[4 * j + q] = *(const f32x4*)(s + 1024 * j + 16 * lane + 4 * q);
}
__device__ __forceinline__ void utab_quant_store(const Params& p, int row, int lane, const f32x4 (&v)[8]) {
    float am = 0.f;
#pragma unroll
    for (int i = 0; i < 8; ++i) am = fmaxf(am, fmaxf(fmaxf(fabsf(v[i][0]), fabsf(v[i][1])), fmaxf(fabsf(v[i][2]), fabsf(v[i][3]))));
    am = wave_max_nonneg(am);
#if U_FP6
    const float sc = am > 0.f ? am * (1.f / 7.5f) : 1.f, inv = am > 0.f ? 7.5f / am : 0.f;
    if (lane == 0) ((float*)(p.ws + WS_USC))[row] = sc;
    f32x16v a, b;
#pragma unroll
    for (int i = 0; i < 8; ++i) { a[2 * i] = v[i][0] * inv; b[2 * i] = v[i][1] * inv; a[2 * i + 1] = v[i][2] * inv; b[2 * i + 1] = v[i][3] * inv; }
    const u32x6v pk = pack_fp6_2x16(a, b);
    unsigned char* d = p.ws + WS_UQ + (size_t)row * UROW;
    *(u32x4*)(d + 16 * lane) = (u32x4){pk[0], pk[1], pk[2], pk[3]};
    *(u32x2*)(d + 1024 + 8 * lane) = (u32x2){pk[4], pk[5]};
#else
    const float sc = am > 0.f ? am * (1.f / 127.f) : 1.f, inv = am > 0.f ? 127.f / am : 0.f;
    if (lane == 0) ((float*)(p.ws + WS_USC))[row] = sc;
#pragma unroll
    for (int j = 0; j < 2; ++j) {
        unsigned wds[4];
#pragma unroll
        for (int q = 0; q < 4; ++q) { unsigned wd = 0;
#pragma unroll
            for (int k = 0; k < 4; ++k) { int qi = (int)rintf(v[4 * j + q][k] * inv); qi = qi < -127 ? -127 : (qi > 127 ? 127 : qi); wd |= ((unsigned)qi & 0xffu) << (8 * k); }
            wds[q] = wd; }
        *(u32x4*)(p.ws + WS_UQ + (size_t)row * DM + 1024 * j + 16 * lane) = (u32x4){wds[0], wds[1], wds[2], wds[3]};
    }
#endif
}
__device__ __forceinline__ void quantize_row_fp6(const float* src, unsigned char* dst, float* scales, int row, int lane) {
    const float* s = src + (size_t)row * DM;
    f32x4 v[8]; float am = 0.f;
#pragma unroll
    for (int j = 0; j < 2; ++j)
#pragma unroll
        for (int q = 0; q < 4; ++q) { v[4 * j + q] = *(const f32x4*)(s + 1024 * j + 16 * lane + 4 * q);
            am = fmaxf(am, fmaxf(fmaxf(fabsf(v[4 * j + q][0]), fabsf(v[4 * j + q][1])), fmaxf(fabsf(v[4 * j + q][2]), fabsf(v[4 * j + q][3])))); }
    am = wave_max_nonneg(am);
    const float sc = am > 0.f ? am * (1.f / 7.5f) : 1.f, inv = am > 0.f ? 7.5f / am : 0.f;
    if (lane == 0) scales[row] = sc;
    f32x16v a, b;
#pragma unroll
    for (int i = 0; i < 8; ++i) { a[2 * i] = v[i][0] * inv; b[2 * i] = v[i][1] * inv; a[2 * i + 1] = v[i][2] * inv; b[2 * i + 1] = v[i][3] * inv; }
    const u32x6v pk = pack_fp6_2x16(a, b);
    unsigned char* d = dst + (size_t)row * VROW;
    *(u32x4*)(d + 16 * lane) = (u32x4){pk[0], pk[1], pk[2], pk[3]};
    *(u32x2*)(d + 1024 + 8 * lane) = (u32x2){pk[4], pk[5]};
}
__device__ __forceinline__ void quantize_row_fp4(const float* src, unsigned char* dst, float* scales, int row, int lane) {
    const float* s = src + (size_t)row * DM;
    f32x4 v[8]; float am = 0.f;
#pragma unroll
    for (int j = 0; j < 2; ++j)
#pragma unroll
        for (int q = 0; q < 4; ++q) { v[4 * j + q] = *(const f32x4*)(s + 1024 * j + 16 * lane + 4 * q);
            am = fmaxf(am, fmaxf(fmaxf(fabsf(v[4 * j + q][0]), fabsf(v[4 * j + q][1])), fmaxf(fabsf(v[4 * j + q][2]), fabsf(v[4 * j + q][3])))); }
    am = wave_max_nonneg(am);
    const float sc = am > 0.f ? am * (1.f / 6.f) : 1.f, inv = am > 0.f ? 6.f / am : 0.f;
    if (lane == 0) scales[row] = sc;
    unsigned wd[4];
#pragma unroll
    for (int q = 0; q < 4; ++q) {
        unsigned w = 0;
        w = __builtin_amdgcn_cvt_scalef32_pk_fp4_f32(w, v[2 * q][0] * inv, v[2 * q][1] * inv, 1.0f, 0);
        w = __builtin_amdgcn_cvt_scalef32_pk_fp4_f32(w, v[2 * q][2] * inv, v[2 * q][3] * inv, 1.0f, 1);
        w = __builtin_amdgcn_cvt_scalef32_pk_fp4_f32(w, v[2 * q + 1][0] * inv, v[2 * q + 1][1] * inv, 1.0f, 2);
        w = __builtin_amdgcn_cvt_scalef32_pk_fp4_f32(w, v[2 * q + 1][2] * inv, v[2 * q + 1][3] * inv, 1.0f, 3);
        wd[q] = w;
    }
    *(u32x4*)(dst + (size_t)row * VROW + 16 * lane) = (u32x4){wd[0], wd[1], wd[2], wd[3]};
}
__device__ __forceinline__ void quantize_row_fp8(const float* src, unsigned char* dst, float* scales, int row, int lane) {
    const float* s = src + (size_t)row * DM;
    f32x4 v[8]; float am = 0.f;
#pragma unroll
    for (int j = 0; j < 2; ++j)
#pragma unroll
        for (int q = 0; q < 4; ++q) { v[4 * j + q] = *(const f32x4*)(s + 1024 * j + 16 * lane + 4 * q);
            am = fmaxf(am, fmaxf(fmaxf(fabsf(v[4 * j + q][0]), fabsf(v[4 * j + q][1])), fmaxf(fabsf(v[4 * j + q][2]), fabsf(v[4 * j + q][3])))); }
    am = wave_max_nonneg(am);
    const float sc = am > 0.f ? am * (1.f / 448.f) : 1.f, inv = am > 0.f ? 448.f / am : 0.f;
    if (lane == 0) scales[row] = sc;
#pragma unroll
    for (int j = 0; j < 2; ++j) {
        unsigned wds[4];
#pragma unroll
        for (int q = 0; q < 4; ++q) {
            int wd = __builtin_amdgcn_cvt_pk_fp8_f32(v[4 * j + q][0] * inv, v[4 * j + q][1] * inv, 0, false);
            wd = __builtin_amdgcn_cvt_pk_fp8_f32(v[4 * j + q][2] * inv, v[4 * j + q][3] * inv, wd, true);
            wds[q] = (unsigned)wd;
        }
        *(u32x4*)(dst + (size_t)row * DM + 1024 * j + 16 * lane) = (u32x4){wds[0], wds[1], wds[2], wds[3]};
    }
}
constexpr int TRS = 260;
__device__ __forceinline__ void tr_loop(const float* W, bf16_t* WT, int N, int ldk, int koff, int ntiles, int first, int G, LAS float* scr, int tid) {
    const int nb = N / 256;
    const int r0 = tid >> 6, cq = tid & 63;
    const int n = tid >> 1, kc = tid & 1;
    for (int r = first; r < ntiles; r += G) {
        const int k0 = (r / nb) * 64, n0 = (r % nb) * 256;
        f32x4 v[8];
#pragma unroll
        for (int i = 0; i < 8; ++i) v[i] = *(const f32x4*)(W + (size_t)(k0 + r0 + 8 * i) * N + n0 + cq * 4);
#pragma unroll
        for (int i = 0; i < 8; ++i) *(LAS f32x4*)(scr + (r0 + 8 * i) * TRS + cq * 4) = v[i];
        __syncthreads();
        const LAS float* s = scr + (kc * 32) * TRS + n;
        bf16_t* dst = WT + (size_t)(n0 + n) * ldk + koff + k0 + kc * 32;
#pragma unroll
        for (int q = 0; q < 4; ++q) {
            u32x4 o; o.x = pk2(s[(8 * q) * TRS], s[(8 * q + 1) * TRS]); o.y = pk2(s[(8 * q + 2) * TRS], s[(8 * q + 3) * TRS]);
            o.z = pk2(s[(8 * q + 4) * TRS], s[(8 * q + 5) * TRS]); o.w = pk2(s[(8 * q + 6) * TRS], s[(8 * q + 7) * TRS]);
            *(u32x4*)(dst + 8 * q) = o;
        }
        __syncthreads();
    }
}
__device__ __forceinline__ void colblock_quant(const float* W, int N, unsigned char* WQ, float* scales, int n0, LAS float* scr, int tid) {
    const int r0 = tid >> 4, cq = tid & 15;
    LAS float* red = scr + 64 * 65;
    f32x4 am = {0.f, 0.f, 0.f, 0.f};
#pragma unroll 8
    for (int i = 0; i < DM / 32; ++i) {
        const f32x4 v = *(const f32x4*)(W + (size_t)(r0 + 32 * i) * N + n0 + cq * 4);
        am[0] = fmaxf(am[0], fabsf(v[0])); am[1] = fmaxf(am[1], fabsf(v[1])); am[2] = fmaxf(am[2], fabsf(v[2])); am[3] = fmaxf(am[3], fabsf(v[3]));
    }
    *(LAS f32x4*)(red + r0 * 64 + cq * 4) = am;
    __syncthreads();
    if (tid < 64) { float m = 0.f; for (int g = 0; g < 32; ++g) m = fmaxf(m, red[g * 64 + tid]); scales[n0 + tid] = m > 0.f ? m * (1.f / 127.f) : 1.f; red[32 * 64 + tid] = m > 0.f ? 127.f / m : 0.f; }
    __syncthreads();
    const f32x4 inv = *(const LAS f32x4*)(red + 32 * 64 + cq * 4);
    const int n = tid >> 3, kc = tid & 7;
    f32x4 v[2];
#pragma unroll
    for (int i = 0; i < 2; ++i) v[i] = *(const f32x4*)(W + (size_t)(r0 + 32 * i) * N + n0 + cq * 4);
    for (int kt = 0; kt < DM / 64; ++kt) {
#pragma unroll
        for (int i = 0; i < 2; ++i) { LAS float* dd = scr + (r0 + 32 * i) * 65 + cq * 4; dd[0] = rintf(v[i][0] * inv[0]); dd[1] = rintf(v[i][1] * inv[1]); dd[2] = rintf(v[i][2] * inv[2]); dd[3] = rintf(v[i][3] * inv[3]); }
        __syncthreads();
        if (kt + 1 < DM / 64) {
#pragma unroll
            for (int i = 0; i < 2; ++i) v[i] = *(const f32x4*)(W + (size_t)((kt + 1) * 64 + r0 + 32 * i) * N + n0 + cq * 4);
        }
        { const LAS float* s = scr + (kc * 8) * 65 + n;
          unsigned lo = 0, hi = 0;
#pragma unroll
          for (int e = 0; e < 4; ++e) { lo |= ((unsigned)(int)s[e * 65] & 0xffu) << (8 * e); hi |= ((unsigned)(int)s[(4 + e) * 65] & 0xffu) << (8 * e); }
          *(u32x2*)(WQ + (size_t)(n0 + n) * DM + kt * 64 + kc * 8) = (u32x2){lo, hi}; }
        __syncthreads();
    }
}
__device__ __forceinline__ void phase_conv(const Params& p, LAS unsigned char* lds, int wg, int G) {
    LAS float* scr = (LAS float*)lds;
    const int tid = opaque_tid();
    {
        constexpr int T_IN = (DM / 64) * (DIN / 256), T_AB = (HW / 64) * (DM / 256), T_SQ = (DM / 64) * (DM / 256);
        int base = 0;
        tr_loop(p.w_in, (bf16_t*)(p.ws + WS_WINT), DIN, DM, 0, T_IN, (((wg - base) % G) + G) % G, G, scr, tid); base += T_IN;
        tr_loop(p.w_a, (bf16_t*)(p.ws + WS_WAT), DM, 2 * HW, 0, T_AB, (((wg - base) % G) + G) % G, G, scr, tid); base += T_AB;
        tr_loop(p.w_b, (bf16_t*)(p.ws + WS_WAT), DM, 2 * HW, HW, T_AB, (((wg - base) % G) + G) % G, G, scr, tid); base += T_AB;
        tr_loop(p.w_out, (bf16_t*)(p.ws + WS_WOT), DM, DM, 0, T_SQ, (((wg - base) % G) + G) % G, G, scr, tid); base += T_SQ;
        tr_loop(p.peer_wq, (bf16_t*)(p.ws + WS_WQT), DM, DM, 0, T_SQ, (((wg - base) % G) + G) % G, G, scr, tid);
    }
    constexpr int I_SK = PH * 2 * NKEYS * 128 / 4096;
    constexpr int NITEMS = I_SK + 1;
    for (int it = wg; it < NITEMS; it += G) {
        int r = it;
        if (r < I_SK) { convert_chunk(p.subkeys, (bf16_t*)(p.ws + WS_SKB), (size_t)r * 4096, tid); continue; } r -= I_SK;
        float* lb = (float*)(p.ws + WS_LB);
        for (int j = tid; j < HW; j += NTHR) { const float l0 = p.lb_logits[j], l1 = p.lb_logits[HW + j]; lb[j] = 1.f / (1.f + __expf(l1 - l0)); }
    }
}

__device__ __forceinline__ void phase_vtab(const Params& p, int sub, int nsub) {
    const int tid = opaque_tid();
    for (int r = sub; r < NEXP / 8; r += nsub) {
#if V_FP4
        quantize_row_fp4(p.peer_v, p.ws + WS_VQ, (float*)(p.ws + WS_VSC), r * 8 + (tid >> 6), tid & 63);
#elif V_FP6
        quantize_row_fp6(p.peer_v, p.ws + WS_VQ, (float*)(p.ws + WS_VSC), r * 8 + (tid >> 6), tid & 63);
#else
        quantize_row_fp8(p.peer_v, p.ws + WS_VQ, (float*)(p.ws + WS_VSC), r * 8 + (tid >> 6), tid & 63);
#endif
    }
}

__device__ __forceinline__ void quant_rows_bf16(const bf16_t* wt, unsigned char* wq, float* sws, int nrows, int wg, int G, int w, int lane) {
#pragma unroll 3
    for (int row = wg * 8 + w; row < nrows; row += G * 8) {
        float v[32]; float am = 0.f;
#pragma unroll
        for (int j = 0; j < 2; ++j)
#pragma unroll
            for (int q = 0; q < 2; ++q) {
                const u32x4 r = *(const u32x4*)(wt + (size_t)row * DM + 1024 * j + 16 * lane + 8 * q);
                float* vp = v + 16 * j + 8 * q;
                vp[0] = bf_lo(r.x); vp[1] = bf_hi(r.x); vp[2] = bf_lo(r.y); vp[3] = bf_hi(r.y); vp[4] = bf_lo(r.z); vp[5] = bf_hi(r.z); vp[6] = bf_lo(r.w); vp[7] = bf_hi(r.w);
            }
#pragma unroll
        for (int i = 0; i < 32; ++i) am = fmaxf(am, fabsf(v[i]));
        am = wave_max_nonneg(am);
        const float sc_ = am > 0.f ? am * (1.f / 127.f) : 1.f, inv = am > 0.f ? 127.f / am : 0.f;
        if (lane == 0) sws[row] = sc_;
#pragma unroll
        for (int j = 0; j < 2; ++j) {
            unsigned wd[4];
#pragma unroll
            for (int q = 0; q < 4; ++q) { unsigned x4 = 0;
#pragma unroll
                for (int e = 0; e < 4; ++e) { const int qi = (int)rintf(v[16 * j + 4 * q + e] * inv); x4 |= ((unsigned)qi & 0xffu) << (8 * e); }
                wd[q] = x4; }
            *(u32x4*)(wq + (size_t)row * DM + 1024 * j + 16 * lane) = (u32x4){wd[0], wd[1], wd[2], wd[3]};
        }
    }
}
__device__ __forceinline__ int prm_col(int s) { return 1024 * (s >> 8) + 16 * (s & 63) + 4 * ((s >> 6) & 3); }
__device__ __forceinline__ void phase_hmod(const Params& p, LAS unsigned char* lds, int wg, int G) {
    const int tid = opaque_tid(), w = tid >> 6, lane = tid & 63;
    const float* mod = (const float*)(p.ws + WS_MOD);
    unsigned char* hq = p.ws + WS_HBF; float* shs = (float*)(p.ws + WS_SH);
    __syncthreads();
    { const int c_ = prm_col(tid);
#pragma unroll
      for (int b_ = 0; b_ < NB; ++b_) {
          *(LAS f32x4*)(lds + (2 * b_) * 8192 + tid * 16) = 1.f + *(const f32x4*)(mod + b_ * 6 * DM + DM + c_);
          *(LAS f32x4*)(lds + (2 * b_ + 1) * 8192 + tid * 16) = *(const f32x4*)(mod + b_ * 6 * DM + c_);
      } }
    __syncthreads();
#pragma unroll 2
    for (int row = wg * 8 + w; row < NT; row += G * 8) {
        const int b = row / SEQ;
        f32x4 h[8]; float am = 0.f;
#pragma unroll
        for (int j = 0; j < 2; ++j)
#pragma unroll
            for (int q = 0; q < 4; ++q) {
                const int c = 1024 * j + 16 * lane + 4 * q, po = ((4 * j + q) * 64 + lane) * 16;
                const f32x4 xv = *(const f32x4*)(p.x + (size_t)row * DM + c), sc1 = *(LAS const f32x4*)(lds + (2 * b) * 8192 + po), sh = *(LAS const f32x4*)(lds + (2 * b + 1) * 8192 + po);
                h[4 * j + q] = xv * sc1 + sh;
                am = fmaxf(am, fmaxf(fmaxf(fabsf(h[4 * j + q][0]), fabsf(h[4 * j + q][1])), fmaxf(fabsf(h[4 * j + q][2]), fabsf(h[4 * j + q][3]))));
            }
        am = wave_max_nonneg(am);
        const float sc_ = am > 0.f ? am * (1.f / 127.f) : 1.f, inv = am > 0.f ? 127.f / am : 0.f;
        if (lane == 0) shs[row] = sc_;
#pragma unroll
        for (int j = 0; j < 2; ++j) {
            unsigned wd[4];
#pragma unroll
            for (int q = 0; q < 4; ++q) { unsigned x4 = 0;
#pragma unroll
                for (int e = 0; e < 4; ++e) { const int qi = (int)rintf(h[4 * j + q][e] * inv); x4 |= ((unsigned)qi & 0xffu) << (8 * e); }
                wd[q] = x4; }
            *(u32x4*)(hq + (size_t)row * DM + 1024 * j + 16 * lane) = (u32x4){wd[0], wd[1], wd[2], wd[3]};
        }
    }

    quant_rows_bf16((const bf16_t*)(p.ws + WS_WINT), p.ws + WS_WQ8, (float*)(p.ws + WS_SW), DIN, wg, G, w, lane);
    quant_rows_bf16((const bf16_t*)(p.ws + WS_WQT), p.ws + WS_WQ8B, (float*)(p.ws + WS_SWQ), DM, wg, G, w, lane);
}
namespace pg8 {
constexpr int BM = 256, BK = 64, HALF = 128, HTB = HALF * BK * 2, STAGE_BYTES = 8 * HTB, NXCD = 8, WGM = 8;
constexpr int SCALE_OFF = STAGE_BYTES, SCALE_BYTES = 2 * 2048;
__host__ __device__ __forceinline__ int lds_byte(int r, int c) { const int st = (r >> 4) * 2 + (c >> 5), rr = r & 15, cc = c & 31, ob = rr * 64 + cc * 2; return st * 1024 + (ob ^ (((ob >> 9) & 1) << 5)); }
__host__ __device__ __forceinline__ void stage_rc(int b, int& R, int& C) { const int st = b / 1024, sb = b % 1024, swz = sb ^ (((sb >> 9) & 1) << 5); R = (st >> 1) * 16 + swz / 64; C = (st & 1) * 32 + (swz % 64) / 2; }
__host__ __device__ __forceinline__ int perm32(int rho) { const int n = rho >> 4, i = rho & 15; return 8 * (i >> 2) + 4 * n + (i & 3); }
struct Unit { int pm, pn; };
struct Gemm { const bf16_t* A; const bf16_t* Bt; int M, N, K; };
struct StaticOrder {
    int nM, nN, nwg, G, c;
    __host__ __device__ void init(int M, int N, int G_, int c_) { nM = M / BM; nN = N / BM; nwg = nM * nN; G = G_; c = c_; }
    __host__ __device__ bool next(int i, Unit& u) const {
        const long L = (long)i * G + c; if (L >= nwg) return false;
        int wgid = (int)L; { const int q = nwg / NXCD, r = nwg % NXCD, xcd = wgid % NXCD, off = wgid / NXCD; wgid = (xcd < r ? xcd * (q + 1) : r * (q + 1) + (xcd - r) * q) + off; }
        const int nig = WGM * nN, gid = wgid / nig, fm = gid * WGM, gsz = (nM - fm) < WGM ? (nM - fm) : WGM;
        u.pm = fm + ((wgid % nig) % gsz); u.pn = (wgid % nig) / gsz; return true;
    }
};
template <class Epi, class Sched>
__device__ __forceinline__ void gemm_phase(LAS unsigned char* lds, const Gemm g, const Sched& S, const Epi& E) {
    const int tid = opaque_tid(), wid = __builtin_amdgcn_readfirstlane(tid >> 6), lane = tid & 63, wr = wid >> 2, wc = wid & 3, fr = lane & 15, fq = lane >> 4;
    const int K = g.K, nt = K / BK;
    unsigned voffA[2], voffB[2];
#pragma unroll
    for (int i = 0; i < 2; ++i) { int R, C; stage_rc(tid * 16 + i * 8192, R, C); const int Rb = Epi::PERM ? ((R & ~31) + perm32(R & 31)) : R;
        voffA[i] = (unsigned)(R * K + C) * 2u; voffB[i] = (unsigned)(Rb * K + C) * 2u; }
    const size_t kstep = (size_t)(BK * 2);
    const size_t hstep = (size_t)HALF * K * 2;
    const size_t tstep = 2 * hstep;
    const unsigned ldsw = (unsigned)wid * 1024u;
    const int aoff = lds_byte(wr * 64 + fr, fq * 8), boff = lds_byte(wc * 32 + fr, fq * 8);
#define PG8_SA(b, h) (((b) * 2 + (h)) * HTB)
#define PG8_SB(b, h) ((4 + (b) * 2 + (h)) * HTB)
#define PG8_STAGE(bufoff, gbase, voff) do { _Pragma("unroll") for (int _i = 0; _i < 2; ++_i) \
        __builtin_amdgcn_global_load_lds((const unsigned*)((const char*)(gbase) + (voff)[_i]), (LAS unsigned*)(lds + (bufoff) + ldsw + _i * 8192), 16, 0, 0); } while (0)
#define PG8_LDA(dst, b, h) do { _Pragma("unroll") for (int m = 0; m < 4; ++m) _Pragma("unroll") for (int k = 0; k < 2; ++k) dst[m][k] = *(const LAS bf16x8*)(lds + PG8_SA(b, h) + aoff + m * 2048 + k * 1024); } while (0)
#define PG8_LDB(dst, b, h) do { _Pragma("unroll") for (int n = 0; n < 2; ++n) _Pragma("unroll") for (int k = 0; k < 2; ++k) dst[n][k] = *(const LAS bf16x8*)(lds + PG8_SB(b, h) + boff + n * 2048 + k * 1024); } while (0)
#define PG8_MMA(ai, bj, At, Bt) do { __builtin_amdgcn_s_setprio(1); _Pragma("unroll") for (int m = 0; m < 4; ++m) _Pragma("unroll") for (int n = 0; n < 2; ++n) _Pragma("unroll") for (int k = 0; k < 2; ++k) \
        { if constexpr (Epi::I8) acc[ai][bj][m][n] = __builtin_bit_cast(acc_t, __builtin_amdgcn_mfma_i32_16x16x64_i8(__builtin_bit_cast(i32x4, Bt[n][k]), __builtin_bit_cast(i32x4, At[m][k]), __builtin_bit_cast(i32x4, acc[ai][bj][m][n]), 0, 0, 0)); \
          else acc[ai][bj][m][n] = __builtin_bit_cast(acc_t, __builtin_amdgcn_mfma_f32_16x16x32_bf16(Bt[n][k], At[m][k], __builtin_bit_cast(f32x4, acc[ai][bj][m][n]), 0, 0, 0)); } __builtin_amdgcn_s_setprio(0); } while (0)
#define PG8_WAIT_V(n) asm volatile("s_waitcnt vmcnt(" #n ")" ::: "memory")
#define PG8_WAIT_L(n) asm volatile("s_waitcnt lgkmcnt(" #n ")" ::: "memory")
#define PG8_BAR __builtin_amdgcn_s_barrier()
#define PG8_SCHED __builtin_amdgcn_sched_barrier(0)
    Unit cur, nxt; int ui = 0;
    if (!S.next(0, cur)) return;
    typedef typename Epi::acc_t acc_t;
    acc_t acc[2][2][4][2];
#pragma unroll
    for (int a = 0; a < 2; ++a)
#pragma unroll
        for (int b = 0; b < 2; ++b)
#pragma unroll
            for (int m = 0; m < 4; ++m)
#pragma unroll
                for (int n = 0; n < 2; ++n) acc[a][b][m][n] = (acc_t){0, 0, 0, 0};
    bf16x8 At[4][2], B0[2][2], B1[2][2];
    const char* cA = (const char*)g.A + (size_t)cur.pm * tstep; const char* cB = (const char*)g.Bt + (size_t)cur.pn * tstep;
#define PG8_SCALES(U, PAR) do { if constexpr (Epi::I8) { const float* src_ = (tid < 256) ? E.rowsc() + (U).pm * 256 + tid : E.colsc() + (U).pn * 256 + (tid - 256); \
        __builtin_amdgcn_global_load_lds((const unsigned*)src_, (LAS unsigned*)(lds + SCALE_OFF + (PAR) * 2048 + wid * 256), 4, 0, 0); } } while (0)
    PG8_SCALES(cur, 0);
    PG8_STAGE(PG8_SB(0, 0), cB, voffB); PG8_STAGE(PG8_SA(0, 0), cA, voffA); PG8_STAGE(PG8_SB(0, 1), cB + hstep, voffB); PG8_STAGE(PG8_SA(0, 1), cA + hstep, voffA);
    if (wr == 1) PG8_BAR;
    PG8_WAIT_V(4); PG8_BAR;
    PG8_STAGE(PG8_SB(1, 0), cB + kstep, voffB); PG8_STAGE(PG8_SA(1, 0), cA + kstep, voffA); PG8_STAGE(PG8_SB(1, 1), cB + hstep + kstep, voffB);
    PG8_WAIT_V(6); PG8_BAR;
    for (;;) {
        const bool has_next = S.next(ui + 1, nxt);
        const char* nA = has_next ? (const char*)g.A + (size_t)nxt.pm * tstep : cA; const char* nB = has_next ? (const char*)g.Bt + (size_t)nxt.pn * tstep : cB;
        for (int t = 0; t < nt; t += 2) {
            const bool last = (t == nt - 2);
            const char* a1 = cA + (size_t)(t + 1) * kstep;
            const char* a2 = last ? nA : cA + (size_t)(t + 2) * kstep; const char* b2 = last ? nB : cB + (size_t)(t + 2) * kstep;
            const char* a3 = a2 + kstep; const char* b3 = b2 + kstep;
            if constexpr (Epi::MID) { if (t == nt / 2) E.mid(acc, cur, wr, wc, fr, fq); }
            PG8_LDB(B0, 0, 0); PG8_SCHED; PG8_LDA(At, 0, 0); PG8_STAGE(PG8_SA(1, 1), a1 + hstep, voffA);
            PG8_WAIT_L(8); PG8_BAR; PG8_WAIT_L(0); PG8_MMA(0, 0, At, B0); PG8_BAR; PG8_SCHED;
            PG8_LDB(B1, 0, 1); PG8_STAGE(PG8_SB(0, 0), b2, voffB);
            PG8_BAR; PG8_WAIT_L(0); PG8_MMA(0, 1, At, B1); PG8_BAR;
            PG8_LDA(At, 0, 1); PG8_STAGE(PG8_SA(0, 0), a2, voffA);
            PG8_BAR; PG8_WAIT_L(0); PG8_MMA(1, 0, At, B0); PG8_BAR; PG8_SCHED;
            PG8_STAGE(PG8_SB(0, 1), b2 + hstep, voffB);
            PG8_WAIT_V(6); PG8_BAR; PG8_MMA(1, 1, At, B1); PG8_BAR;
            PG8_LDB(B0, 1, 0); PG8_SCHED; PG8_LDA(At, 1, 0); PG8_STAGE(PG8_SA(0, 1), a2 + hstep, voffA);
            PG8_WAIT_L(8); PG8_BAR; PG8_WAIT_L(0); PG8_MMA(0, 0, At, B0); PG8_BAR; PG8_SCHED;
            PG8_LDB(B1, 1, 1); PG8_STAGE(PG8_SB(1, 0), b3, voffB);
            PG8_BAR; PG8_WAIT_L(0); PG8_MMA(0, 1, At, B1); PG8_BAR;
            PG8_LDA(At, 1, 1); PG8_STAGE(PG8_SA(1, 0), a3, voffA);
            PG8_BAR; PG8_WAIT_L(0); PG8_MMA(1, 0, At, B0); PG8_BAR; PG8_SCHED;
            PG8_STAGE(PG8_SB(1, 1), b3 + hstep, voffB);
            PG8_WAIT_V(6); PG8_BAR; PG8_MMA(1, 1, At, B1); PG8_BAR;
        }
        if constexpr (Epi::I8) E(acc, cur, wr, wc, fr, fq, (const LAS float*)(lds + SCALE_OFF + (ui & 1) * 2048)); else E(acc, cur, wr, wc, fr, fq);
        if (!has_next) break;
#pragma unroll
        for (int a = 0; a < 2; ++a)
#pragma unroll
            for (int b = 0; b < 2; ++b)
#pragma unroll
                for (int m = 0; m < 4; ++m)
#pragma unroll
                    for (int n = 0; n < 2; ++n) acc[a][b][m][n] = (acc_t){0, 0, 0, 0};
        cur = nxt; cA = nA; cB = nB; ++ui;
        PG8_SCALES(cur, ui & 1);
    }
    PG8_WAIT_V(0);
    if (wr == 0) PG8_BAR;
    PG8_BAR;
#undef PG8_SCALES
#undef PG8_SA
#undef PG8_SB
#undef PG8_STAGE
#undef PG8_LDA
#undef PG8_LDB
#undef PG8_MMA
#undef PG8_WAIT_V
#undef PG8_WAIT_L
#undef PG8_BAR
#undef PG8_SCHED
}
}

struct EpiProj {
    typedef i32x4 acc_t; static constexpr bool PERM = true, MID = false, I8 = true;
    unsigned char* ws;
    __device__ __forceinline__ const float* rowsc() const { return (const float*)(ws + WS_SH); }
    __device__ __forceinline__ const float* colsc() const { return (const float*)(ws + WS_SW); }
    __device__ __forceinline__ void operator()(const i32x4 (&iacc)[2][2][4][2], const pg8::Unit& u, int wr, int wc, int fr, int fq, const LAS float* sc) const {
        const int row0 = u.pm * 256 + wr * 64 + fr, pn = u.pn;
        f32x4 acc[2][2][4][2];
        { f32x4 cw[2][2];
#pragma unroll
          for (int bj = 0; bj < 2; ++bj)
#pragma unroll
              for (int n = 0; n < 2; ++n) cw[bj][n] = *(const LAS f32x4*)(sc + 256 + bj * 128 + wc * 32 + 8 * fq + 4 * n);
#pragma unroll
          for (int ai = 0; ai < 2; ++ai)
#pragma unroll
              for (int m = 0; m < 4; ++m) { const float rs = sc[wr * 64 + fr + ai * 128 + m * 16];
#pragma unroll
                  for (int bj = 0; bj < 2; ++bj)
#pragma unroll
                      for (int n = 0; n < 2; ++n)
#pragma unroll
                          for (int j = 0; j < 4; ++j) acc[ai][bj][m][n][j] = (float)iacc[ai][bj][m][n][j] * rs * cw[bj][n][j]; } }
        const int cin = wc * 32 + 8 * fq;
        int seg, cbase;
        if (pn < 28) { seg = pn >> 2; cbase = (pn & 3) * 256; } else if (pn < 36) { seg = 7; cbase = (pn - 28) * 256; } else { seg = 8; cbase = (pn - 36) * 256; }
        if (seg == 2) {
            bf16_t* vt = (bf16_t*)(ws + WS_VT);
#pragma unroll
            for (int ai = 0; ai < 2; ++ai)
#pragma unroll
                for (int m = 0; m < 4; ++m) {
                    const int row = row0 + ai * 128 + m * 16, b = row / SEQ, s = row % SEQ;
#pragma unroll
                    for (int bj = 0; bj < 2; ++bj) {
                        const int c = cbase + bj * 128 + cin, h = c >> 7, d = c & 127;
                        bf16_t* dst = vt + ((size_t)((b * NH + h) * HD + d)) * SEQ + s;
#pragma unroll
                        for (int n = 0; n < 2; ++n)
#pragma unroll
                            for (int j = 0; j < 4; ++j) dst[(size_t)(n * 4 + j) * SEQ] = f2bf(acc[ai][bj][m][n][j]);
                    }
                }
            return;
        }
        bf16_t* base; int ldc;
        switch (seg) {
            case 0: base = (bf16_t*)(ws + WS_Q); ldc = HW; break;
            case 1: base = (bf16_t*)(ws + WS_K); ldc = HW; break;
            case 3: base = (bf16_t*)(ws + WS_HQ); ldc = HW; break;
            case 4: base = (bf16_t*)(ws + WS_HF); ldc = HW; break;
            case 5: base = (bf16_t*)(ws + WS_HI); ldc = HW; break;
            case 6: base = (bf16_t*)(ws + WS_HG); ldc = HW; break;
            case 7: base = (bf16_t*)(ws + WS_GA); ldc = DM; break;
            default: base = (bf16_t*)(ws + WS_GB); ldc = DM; break;
        }
        const float qs = 0.08838834764831845f * LOG2E;
#define EPI_BODY(FN) { _Pragma("unroll") for (int ai = 0; ai < 2; ++ai) _Pragma("unroll") for (int m = 0; m < 4; ++m) { \
                bf16_t* rowp = base + (size_t)(row0 + ai * 128 + m * 16) * ldc + cbase + cin; \
                _Pragma("unroll") for (int bj = 0; bj < 2; ++bj) { \
                    f32x4 v0 = acc[ai][bj][m][0], v1 = acc[ai][bj][m][1]; \
                    _Pragma("unroll") for (int j = 0; j < 4; ++j) { v0[j] = FN(v0[j]); v1[j] = FN(v1[j]); } \
                    u32x4 w; w.x = pk2(v0[0], v0[1]); w.y = pk2(v0[2], v0[3]); w.z = pk2(v1[0], v1[1]); w.w = pk2(v1[2], v1[3]); \
                    *(u32x4*)(rowp + bj * 128) = w; } } }
#define EPI_ID(x) (x)
#define EPI_QS(x) ((x) * qs)
        if (seg == 0) EPI_BODY(EPI_QS)
        else if (seg == 6) EPI_BODY(siluf_)
        else if (seg >= 7) EPI_BODY(sigmoidf_)
        else EPI_BODY(EPI_ID)
#undef EPI_BODY
#undef EPI_ID
#undef EPI_QS
    }
};
struct EpiT1 {
    typedef f32x4 acc_t; static constexpr bool PERM = true, MID = false, I8 = false;
    unsigned char* ws;
    __device__ __forceinline__ void operator()(const f32x4 (&acc)[2][2][4][2], const pg8::Unit& u, int wr, int wc, int fr, int fq) const {
        const int row0 = u.pm * 256 + wr * 64 + fr, col0 = u.pn * 256 + wc * 32 + 8 * fq;
        const bf16_t* ga = (const bf16_t*)(ws + WS_GA); float* t1 = (float*)(ws + WS_R1);
#pragma unroll
        for (int ai = 0; ai < 2; ++ai)
#pragma unroll
            for (int m = 0; m < 4; ++m)
#pragma unroll
                for (int bj = 0; bj < 2; ++bj) {
                    const size_t off = (size_t)(row0 + ai * 128 + m * 16) * DM + col0 + bj * 128;
                    const u32x4 g = *(const u32x4*)(ga + off);
                    f32x4 v0 = acc[ai][bj][m][0], v1 = acc[ai][bj][m][1];
                    v0[0] *= bf_lo(g.x); v0[1] *= bf_hi(g.x); v0[2] *= bf_lo(g.y); v0[3] *= bf_hi(g.y);
                    v1[0] *= bf_lo(g.z); v1[1] *= bf_hi(g.z); v1[2] *= bf_lo(g.w); v1[3] *= bf_hi(g.w);
                    *(f32x4*)(t1 + off) = v0; *(f32x4*)(t1 + off + 4) = v1;
                }
    }
};
struct EpiMerge {
    typedef f32x4 acc_t; static constexpr bool PERM = true, MID = false, I8 = false;
    unsigned char* ws;
    __device__ __forceinline__ void operator()(const f32x4 (&acc)[2][2][4][2], const pg8::Unit& u, int wr, int wc, int fr, int fq) const {
        const int row0 = u.pm * 256 + wr * 64 + fr, col0 = u.pn * 256 + wc * 32 + 8 * fq;
        const bf16_t* gb = (const bf16_t*)(ws + WS_GB); const float* t1 = (const float*)(ws + WS_R1); bf16_t* mg = (bf16_t*)(ws + WS_MERGED);
#pragma unroll
        for (int ai = 0; ai < 2; ++ai)
#pragma unroll
            for (int m = 0; m < 4; ++m)
#pragma unroll
                for (int bj = 0; bj < 2; ++bj) {
                    const size_t off = (size_t)(row0 + ai * 128 + m * 16) * DM + col0 + bj * 128;
                    const u32x4 g = *(const u32x4*)(gb + off);
                    f32x4 v0 = acc[ai][bj][m][0], v1 = acc[ai][bj][m][1];
                    const f32x4 t0 = *(const f32x4*)(t1 + off), t4 = *(const f32x4*)(t1 + off + 4);
                    v0[0] = v0[0] * bf_lo(g.x) + t0[0]; v0[1] = v0[1] * bf_hi(g.x) + t0[1]; v0[2] = v0[2] * bf_lo(g.y) + t0[2]; v0[3] = v0[3] * bf_hi(g.y) + t0[3];
                    v1[0] = v1[0] * bf_lo(g.z) + t4[0]; v1[1] = v1[1] * bf_hi(g.z) + t4[1]; v1[2] = v1[2] * bf_lo(g.w) + t4[2]; v1[3] = v1[3] * bf_hi(g.w) + t4[3];
                    u32x4 w; w.x = pk2(v0[0], v0[1]); w.y = pk2(v0[2], v0[3]); w.z = pk2(v1[0], v1[1]); w.w = pk2(v1[2], v1[3]);
                    *(u32x4*)(mg + off) = w;
                }
    }
};
struct EpiRes1 {
    typedef f32x4 acc_t; static constexpr bool PERM = true, MID = false, I8 = false;
    unsigned char* ws; const float* x;
    __device__ __forceinline__ void operator()(const f32x4 (&acc)[2][2][4][2], const pg8::Unit& u, int wr, int wc, int fr, int fq) const {
        const int row0 = u.pm * 256 + wr * 64 + fr, col0 = u.pn * 256 + wc * 32 + 8 * fq;
        const float* mod = (const float*)(ws + WS_MOD); bf16_t* r1 = (bf16_t*)(ws + WS_R1);
        const int b = (u.pm * 256) / SEQ;
        f32x4 g1[2][2];
#pragma unroll
        for (int bj = 0; bj < 2; ++bj)
#pragma unroll
            for (int n = 0; n < 2; ++n) g1[bj][n] = 1.f + *(const f32x4*)(mod + b * 6 * DM + 2 * DM + col0 + bj * 128 + 4 * n);
#pragma unroll
        for (int ai = 0; ai < 2; ++ai)
#pragma unroll
            for (int m = 0; m < 4; ++m) {
                const size_t ro = (size_t)(row0 + ai * 128 + m * 16) * DM + col0;
#pragma unroll
                for (int bj = 0; bj < 2; ++bj) {
                    const f32x4 x0 = *(const f32x4*)(x + ro + bj * 128), x1 = *(const f32x4*)(x + ro + bj * 128 + 4);
                    const f32x4 v0 = ALPHA * x0 + g1[bj][0] * acc[ai][bj][m][0], v1 = ALPHA * x1 + g1[bj][1] * acc[ai][bj][m][1];
                    u32x4 w; w.x = pk2(v0[0], v0[1]); w.y = pk2(v0[2], v0[3]); w.z = pk2(v1[0], v1[1]); w.w = pk2(v1[2], v1[3]);
                    *(u32x4*)(r1 + ro + bj * 128) = w;
                }
            }
    }
};
struct EpiQP {
    typedef f32x4 acc_t; static constexpr bool PERM = true, MID = false, I8 = false;
    unsigned char* ws;
    __device__ __forceinline__ void operator()(const f32x4 (&acc)[2][2][4][2], const pg8::Unit& u, int wr, int wc, int fr, int fq) const {
        const int row0 = u.pm * 256 + wr * 64 + fr, col0 = u.pn * 256 + wc * 32 + 8 * fq;
        bf16_t* qp = (bf16_t*)(ws + WS_QP);
#pragma unroll
        for (int ai = 0; ai < 2; ++ai)
#pragma unroll
            for (int m = 0; m < 4; ++m)
#pragma unroll
                for (int bj = 0; bj < 2; ++bj) {
                    const size_t off = (size_t)(row0 + ai * 128 + m * 16) * DM + col0 + bj * 128;
                    const f32x4 v0 = acc[ai][bj][m][0], v1 = acc[ai][bj][m][1];
                    u32x4 w; w.x = pk2(v0[0], v0[1]); w.y = pk2(v0[2], v0[3]); w.z = pk2(v1[0], v1[1]); w.w = pk2(v1[2], v1[3]);
                    *(u32x4*)(qp + off) = w;
                }
    }
};

struct EpiMerge2 {
    typedef f32x4 acc_t; static constexpr bool PERM = true, MID = true, I8 = false;
    unsigned char* ws;
    __device__ __forceinline__ void mid(f32x4 (&acc)[2][2][4][2], const pg8::Unit& u, int wr, int wc, int fr_in, int fq) const {
        int fr = fr_in; asm volatile("" : "+v"(fr));
        const int row0 = u.pm * 256 + wr * 64 + fr, col0 = u.pn * 256 + wc * 32 + 8 * fq;
        const bf16_t* ga = (const bf16_t*)(ws + WS_GA); const bf16_t* gb = (const bf16_t*)(ws + WS_GB);
#pragma unroll
        for (int ai = 0; ai < 2; ++ai)
#pragma unroll
            for (int mp = 0; mp < 2; ++mp) {
                u32x4 a[2][2], b[2][2];
#pragma unroll
                for (int mi = 0; mi < 2; ++mi)
#pragma unroll
                    for (int bj = 0; bj < 2; ++bj) {
                        const size_t off = (size_t)(row0 + ai * 128 + (2 * mp + mi) * 16) * DM + col0 + bj * 128;
                        a[mi][bj] = *(const u32x4*)(ga + off); b[mi][bj] = *(const u32x4*)(gb + off);
                    }
#pragma unroll
                for (int mi = 0; mi < 2; ++mi)
#pragma unroll
                    for (int bj = 0; bj < 2; ++bj) {
                        const int m = 2 * mp + mi;
                        const unsigned aw[4] = {a[mi][bj].x, a[mi][bj].y, a[mi][bj].z, a[mi][bj].w}, bw[4] = {b[mi][bj].x, b[mi][bj].y, b[mi][bj].z, b[mi][bj].w};
#pragma unroll
                        for (int q = 0; q < 4; ++q) {
                            const float r0 = bf_lo(aw[q]) * fast_rcp(fmaxf(bf_lo(bw[q]), 1e-20f)), r1 = bf_hi(aw[q]) * fast_rcp(fmaxf(bf_hi(bw[q]), 1e-20f));
                            acc[ai][bj][m][q >> 1][2 * (q & 1)] *= r0; acc[ai][bj][m][q >> 1][2 * (q & 1) + 1] *= r1;
                        }
                    }
                asm volatile("" ::: "memory");
            }
    }
    __device__ __forceinline__ void operator()(const f32x4 (&acc)[2][2][4][2], const pg8::Unit& u, int wr, int wc, int fr, int fq) const {
        const int row0 = u.pm * 256 + wr * 64 + fr, col0 = u.pn * 256 + wc * 32 + 8 * fq;
        const bf16_t* gb = (const bf16_t*)(ws + WS_GB); bf16_t* mg = (bf16_t*)(ws + WS_MERGED);
#pragma unroll
        for (int ai = 0; ai < 2; ++ai)
#pragma unroll
            for (int m = 0; m < 4; ++m)
#pragma unroll
                for (int bj = 0; bj < 2; ++bj) {
                    const size_t off = (size_t)(row0 + ai * 128 + m * 16) * DM + col0 + bj * 128;
                    const u32x4 g = *(const u32x4*)(gb + off);
                    const f32x4 v0 = acc[ai][bj][m][0], v1 = acc[ai][bj][m][1];
                    u32x4 w;
                    w.x = pk2(v0[0] * fmaxf(bf_lo(g.x), 1e-20f), v0[1] * fmaxf(bf_hi(g.x), 1e-20f)); w.y = pk2(v0[2] * fmaxf(bf_lo(g.y), 1e-20f), v0[3] * fmaxf(bf_hi(g.y), 1e-20f));
                    w.z = pk2(v1[0] * fmaxf(bf_lo(g.z), 1e-20f), v1[1] * fmaxf(bf_hi(g.z), 1e-20f)); w.w = pk2(v1[2] * fmaxf(bf_lo(g.w), 1e-20f), v1[3] * fmaxf(bf_hi(g.w), 1e-20f));
                    *(u32x4*)(mg + off) = w;
                }
    }
};

struct EpiQP8 {
    typedef i32x4 acc_t; static constexpr bool PERM = true, MID = false, I8 = true;
    unsigned char* ws;
    __device__ __forceinline__ const float* rowsc() const { return (const float*)(ws + WS_SH2); }
    __device__ __forceinline__ const float* colsc() const { return (const float*)(ws + WS_SWQ); }
    __device__ __forceinline__ void operator()(const i32x4 (&acc)[2][2][4][2], const pg8::Unit& u, int wr, int wc, int fr, int fq, const LAS float* sc) const {
        const int row0 = u.pm * 256 + wr * 64 + fr, col0 = u.pn * 256 + wc * 32 + 8 * fq;
        bf16_t* qp = (bf16_t*)(ws + WS_QP);
        f32x4 cw[2][2];
#pragma unroll
        for (int bj = 0; bj < 2; ++bj)
#pragma unroll
            for (int n = 0; n < 2; ++n) cw[bj][n] = *(const LAS f32x4*)(sc + 256 + bj * 128 + wc * 32 + 8 * fq + 4 * n);
#pragma unroll
        for (int ai = 0; ai < 2; ++ai)
#pragma unroll
            for (int m = 0; m < 4; ++m) {
                const float rs = sc[wr * 64 + fr + ai * 128 + m * 16];
#pragma unroll
                for (int bj = 0; bj < 2; ++bj) {
                    const size_t off = (size_t)(row0 + ai * 128 + m * 16) * DM + col0 + bj * 128;
                    float v[8];
#pragma unroll
                    for (int n = 0; n < 2; ++n)
#pragma unroll
                        for (int j = 0; j < 4; ++j) v[4 * n + j] = (float)acc[ai][bj][m][n][j] * rs * cw[bj][n][j];
                    u32x4 w; w.x = pk2(v[0], v[1]); w.y = pk2(v[2], v[3]); w.z = pk2(v[4], v[5]); w.w = pk2(v[6], v[7]);
                    *(u32x4*)(qp + off) = w;
                }
            }
    }
};
constexpr float ATT_EXIT = -150.f;
constexpr int ATT_KS_BYTES = 64 * 256, ATT_VT_STRIDE = 136, ATT_VT_BYTES = 128 * ATT_VT_STRIDE;
__device__ __forceinline__ void phase_attn(const Params& p, LAS unsigned char* lds, int wg, int G) {
    const int tid = opaque_tid(), w = __builtin_amdgcn_readfirstlane(tid >> 6), lane = tid & 63, l31 = lane & 31, h2 = lane >> 5;
    const bf16_t* Qg = (const bf16_t*)(p.ws + WS_Q); const bf16_t* Kg = (const bf16_t*)(p.ws + WS_K); const bf16_t* VTg = (const bf16_t*)(p.ws + WS_VT);
    bf16_t* AO = (bf16_t*)(p.ws + WS_AB);
    LAS unsigned char* KsB[2] = {lds, lds + ATT_KS_BYTES};
    LAS unsigned char* VtB[2] = {lds + 2 * ATT_KS_BYTES, lds + 2 * ATT_KS_BYTES + ATT_VT_BYTES};
    volatile LAS int* flags = (volatile LAS int*)(lds + 2 * ATT_KS_BYTES + 2 * ATT_VT_BYTES);
    for (int item = wg; item < NB * NH * 16; item += G) {
        const int bh = item >> 4, qb = item & 15, b = bh >> 3, h = bh & 7, t0 = qb * 256;
        const int tq = t0 + 32 * w + l31;
        const int tq_hi = t0 + 32 * w + 31;
        bf16x8 qf[8];
        { const bf16_t* qrow = Qg + (size_t)(b * SEQ + tq) * HW + h * HD + h2 * 8;
#pragma unroll
          for (int ks = 0; ks < 8; ++ks) qf[ks] = *(const bf16x8*)(qrow + ks * 16); }
        f32x16 o[4];
#pragma unroll
        for (int i = 0; i < 4; ++i)
#pragma unroll
            for (int r = 0; r < 16; ++r) o[i][r] = 0.f;
        float R = 0.f;
        bool wdone = false;
        const int kt_first = (t0 + 256) / 64 - 1;
        u32x4 kreg[2], vreg[2];
        const bf16_t* Kbase = Kg + (size_t)(b * SEQ) * HW + h * HD;
        const bf16_t* Vbase = VTg + (size_t)(bh * HD) * SEQ;
        auto prefetch = [&](int kt) {
#pragma unroll
            for (int i = 0; i < 2; ++i) {
                const int id = tid + i * NTHR;
                const int kr = id >> 4, kc = id & 15;
                kreg[i] = *(const u32x4*)(Kbase + (size_t)(kt * 64 + kr) * HW + kc * 8);
                const int vr = id >> 3, vc = id & 7;
                vreg[i] = *(const u32x4*)(Vbase + (size_t)vr * SEQ + kt * 64 + vc * 8);
            }
        };
        prefetch(kt_first);
        __syncthreads();
        if (tid < 16) flags[tid] = 0;
        int it = 0;
        for (int kt = kt_first; kt >= 0; --kt, ++it) {
            const int cur = it & 1;
#pragma unroll
            for (int i = 0; i < 2; ++i) {
                const int id = tid + i * NTHR;
                const int kr = id >> 4, kc = id & 15;
                *(LAS u32x4*)(KsB[cur] + kr * 256 + ((kc ^ (kr & 15)) << 4)) = kreg[i];
                const int vr = id >> 3, vc = id & 7;
                LAS unsigned char* vd = VtB[cur] + vr * ATT_VT_STRIDE + vc * 16;
                *(LAS u32x2*)vd = (u32x2){vreg[i].x, vreg[i].y}; *(LAS u32x2*)(vd + 8) = (u32x2){vreg[i].z, vreg[i].w};
            }
            __syncthreads();
            if (it > 0) {
                int alld = 1;
#pragma unroll
                for (int j = 0; j < 8; ++j) alld &= flags[((it - 1) & 1) * 8 + j];
                if (alld) break;
            }
            if (kt > 0) prefetch(kt - 1);
            const bool active = !wdone && (kt * 64 < tq_hi);
            if (active) {
#pragma unroll
                for (int kbi = 0; kbi < 2; ++kbi) {
                    const int kb = 1 - kbi;
                    const int key0 = kt * 64 + kb * 32;
                    if (key0 < tq_hi) {
                        f32x16 S;
#pragma unroll
                        for (int r = 0; r < 16; ++r) S[r] = 0.f;
                        const int krow = kb * 32 + l31;
                        const LAS unsigned char* kp = KsB[cur] + krow * 256;
#pragma unroll
                        for (int ks = 0; ks < 8; ++ks) {
                            const bf16x8 a = *(const LAS bf16x8*)(kp + (((ks * 2 + h2) ^ (krow & 15)) << 4));
                            S = __builtin_amdgcn_mfma_f32_32x32x16_bf16(a, qf[ks], S, 0, 0, 0);
                        }
                        float lg[16], zb[16];
#pragma unroll
                        for (int r = 0; r < 16; ++r) {
                            const int key = key0 + (r & 3) + 8 * (r >> 2) + 4 * h2;
                            const float z = S[r];
                            const float sp = fmaxf(z, 0.f) + fast_log2(1.f + fast_exp2(-fabsf(z)));
                            const bool valid = key < tq;
                            lg[r] = valid ? -sp : 0.f;
                            zb[r] = valid ? (z - sp) : -INFINITY;
                        }
                        float g[4], pg[4], tot[4];
#pragma unroll
                        for (int i = 0; i < 4; ++i) { g[i] = (lg[4 * i] + lg[4 * i + 1]) + (lg[4 * i + 2] + lg[4 * i + 3]); pg[i] = __shfl_xor(g[i], 32); tot[i] = g[i] + pg[i]; }
                        float above[4]; above[3] = 0.f; above[2] = tot[3]; above[1] = tot[3] + tot[2]; above[0] = above[1] + tot[1];
                        unsigned wp[8];
#pragma unroll
                        for (int i = 0; i < 4; ++i) {
                            const float off = R + above[i] + (h2 == 0 ? pg[i] : 0.f);
                            const float c3 = off, c2 = c3 + lg[4 * i + 3], c1 = c2 + lg[4 * i + 2], c0 = c1 + lg[4 * i + 1];
                            const float w0 = fast_exp2(zb[4 * i] + c0), w1 = fast_exp2(zb[4 * i + 1] + c1), w2 = fast_exp2(zb[4 * i + 2] + c2), w3 = fast_exp2(zb[4 * i + 3] + c3);
                            wp[2 * i] = pk2(w0, w1); wp[2 * i + 1] = pk2(w2, w3);
                        }
                        R += (tot[0] + tot[1]) + (tot[2] + tot[3]);
#pragma unroll
                        for (int s2 = 0; s2 < 2; ++s2) {
                            bf16x8 bw;
                            { u32x4 t; t.x = wp[4 * s2]; t.y = wp[4 * s2 + 1]; t.z = wp[4 * s2 + 2]; t.w = wp[4 * s2 + 3]; bw = __builtin_bit_cast(bf16x8, t); }
                            const int kk = kb * 32 + 16 * s2 + 4 * h2;
#pragma unroll
                            for (int db = 0; db < 4; ++db) {
                                const LAS unsigned char* vp = VtB[cur] + (db * 32 + l31) * ATT_VT_STRIDE + kk * 2;
                                const u32x2 lo = *(const LAS u32x2*)vp, hi = *(const LAS u32x2*)(vp + 16);
                                u32x4 t; t.x = lo.x; t.y = lo.y; t.z = hi.x; t.w = hi.y;
                                o[db] = __builtin_amdgcn_mfma_f32_32x32x16_bf16(__builtin_bit_cast(bf16x8, t), bw, o[db], 0, 0, 0);
                            }
                        }
                    }
                }
                if (__all(R < ATT_EXIT)) wdone = true;
            }
            if (lane == 0) flags[cur * 8 + w] = wdone ? 1 : 0;
        }
        { bf16_t* orow = AO + (size_t)(b * SEQ + tq) * DM + h * HD;
#pragma unroll
          for (int db = 0; db < 4; ++db)
#pragma unroll
              for (int i = 0; i < 4; ++i) {
                  u32x2 v; v.x = pk2(o[db][4 * i], o[db][4 * i + 1]); v.y = pk2(o[db][4 * i + 2], o[db][4 * i + 3]);
                  *(u32x2*)(orow + db * 32 + 8 * i + 4 * h2) = v;
              } }
    }
    __syncthreads();
}

constexpr int HG_SEGC = 4, HG_NSEG = 16;
constexpr int HG_OFF_AS = 0, HG_OFF_KP = HG_OFF_AS + 64 * 272, HG_OFF_KT = HG_OFF_KP + 64 * 272, HG_OFF_VT = HG_OFF_KT + 128 * 144,
              HG_OFF_PS = HG_OFF_VT + 128 * 144, HG_OFF_ST = HG_OFF_PS + 64 * 144, HG_OFF_GAM = HG_OFF_ST + 128 * 272,
              HG_OFF_RS = HG_OFF_GAM + 512, HG_OFF_GSEG = HG_OFF_RS + 512, HG_OFF_LBS = HG_OFF_GSEG + 512, HG_LDS_END = HG_OFF_LBS + 512;
template <int PASS>
__device__ __forceinline__ void phase_hgrn(const Params& p, LAS unsigned char* lds, int wg, int G) {
    const int tid = opaque_tid(), w = __builtin_amdgcn_readfirstlane(tid >> 6), lane = tid & 63, fr = lane & 15, fq = lane >> 4;
    LAS unsigned char* As = lds + HG_OFF_AS; LAS unsigned char* Kp = lds + HG_OFF_KP; LAS unsigned char* KT = lds + HG_OFF_KT;
    LAS unsigned char* VT = lds + HG_OFF_VT; LAS unsigned char* Ps = lds + HG_OFF_PS; LAS unsigned char* ST = lds + HG_OFF_ST;
    LAS float* gam = (LAS float*)(lds + HG_OFF_GAM); LAS float* rs = (LAS float*)(lds + HG_OFF_RS);
    LAS float* gseg = (LAS float*)(lds + HG_OFF_GSEG); LAS float* lbs = (LAS float*)(lds + HG_OFF_LBS);
    const bf16_t* HQ = (const bf16_t*)(p.ws + WS_HQ); const bf16_t* HF = (const bf16_t*)(p.ws + WS_HF); const bf16_t* HI = (const bf16_t*)(p.ws + WS_HI);
    const bf16_t* HGs = (const bf16_t*)(p.ws + WS_HG); bf16_t* BO = (bf16_t*)(p.ws + WS_AB) + HW;
    const float* lbv = (const float*)(p.ws + WS_LB);
    float* HST = (float*)(p.ws + WS_HST); float* HGAM = (float*)(p.ws + WS_HGAM);
    for (int item = wg; item < NB * NH * HG_NSEG; item += G) {
        const int bh = item / HG_NSEG, seg = item % HG_NSEG, b = bh >> 3, h = bh & 7;
        f32x4 S[8];
#pragma unroll
        for (int eb = 0; eb < 8; ++eb) S[eb] = (f32x4){0.f, 0.f, 0.f, 0.f};
        __syncthreads();
        u32x4 pq[2], pf[2], pv[2];
        { const int tokf = b * SEQ + (seg * HG_SEGC) * 64;
#pragma unroll
          for (int i = 0; i < 2; ++i) {
              const size_t go = (size_t)(tokf + lane) * HW + h * HD + (w + 8 * i) * 8;
              pq[i] = *(const u32x4*)(HQ + go); pf[i] = *(const u32x4*)(HF + go); pv[i] = *(const u32x4*)(HI + go);
          } }
        if (tid < 128) { lbs[tid] = lbv[h * HD + tid]; if (PASS == 0) gseg[tid] = 1.f; }
        if (PASS == 1) {
            f32x4 P4 = {1.f, 1.f, 1.f, 1.f};
            for (int j = seg - 1; j >= 0; --j) {
                const float* Lj = HST + (size_t)(bh * HG_NSEG + j) * (HD * HD);
#pragma unroll
                for (int eb = 0; eb < 8; ++eb)
#pragma unroll
                    for (int jj = 0; jj < 4; ++jj) S[eb][jj] += P4[jj] * Lj[(size_t)(w * 16 + 4 * fq + jj) * HD + eb * 16 + fr];
                P4 *= *(const f32x4*)(HGAM + (size_t)(bh * HG_NSEG + j) * HD + w * 16 + 4 * fq);
                if (__all(P4[0] == 0.f && P4[1] == 0.f && P4[2] == 0.f && P4[3] == 0.f)) break;
            }
#pragma unroll
            for (int eb = 0; eb < 8; ++eb) { u32x2 v; v.x = pk2(S[eb][0], S[eb][1]); v.y = pk2(S[eb][2], S[eb][3]); *(LAS u32x2*)(ST + (eb * 16 + fr) * 272 + (w * 16 + 4 * fq) * 2) = v; }
        }
        f32x4 urv[8];
        { const int urow0 = PASS * (NEXP / 2) + item * (HG_SEGC * 8) + w; if (urow0 < NEXP) utab_load(p, urow0, lane, urv); }
        f32x4 ngv[4];
        if (PASS == 1) {
#pragma unroll
            for (int q = 0; q < 4; ++q) ngv[q] = *(const f32x4*)(p.hg_norm_g + h * HD + (((w & 1) * 4 + q) * 16 + 4 * fq));
        }
        __syncthreads();
        for (int cc = 0; cc < HG_SEGC; ++cc) {
            const int tok0 = b * SEQ + (seg * HG_SEGC + cc) * 64;
            const int urow = PASS * (NEXP / 2) + item * (HG_SEGC * 8) + cc * 8 + w;
            u32x2 ggv[4];
            if (PASS == 1) {
                const int tg_ = tok0 + (w >> 1) * 16 + fr;
#pragma unroll
                for (int q = 0; q < 4; ++q) ggv[q] = *(const u32x2*)(HGs + (size_t)tg_ * HW + h * HD + (((w & 1) * 4 + q) * 16 + 4 * fq));
            }
#pragma unroll
            for (int i = 0; i < 2; ++i) {
                const int t = lane, c8 = w + 8 * i;
                const u32x4 qv = pq[i], fv = pf[i], vv = pv[i];
                const unsigned qa[4] = {qv.x, qv.y, qv.z, qv.w}, fa[4] = {fv.x, fv.y, fv.z, fv.w}, va[4] = {vv.x, vv.y, vv.z, vv.w};
                float av[8], kp[8];
#pragma unroll
                for (int j = 0; j < 8; ++j) {
                    const int d = c8 * 8 + j;
                    const float fp = (j & 1) ? bf_hi(fa[j >> 1]) : bf_lo(fa[j >> 1]);
                    const float lb = lbs[d];
                    const float f = lb + (1.f - lb) * sigmoidf_(fp);
                    float c = f;
                    c *= __int_as_float(__builtin_amdgcn_update_dpp(0x3f800000, __float_as_int(c), 0x111, 0xf, 0xf, false));
                    c *= __int_as_float(__builtin_amdgcn_update_dpp(0x3f800000, __float_as_int(c), 0x112, 0xf, 0xf, false));
                    c *= __int_as_float(__builtin_amdgcn_update_dpp(0x3f800000, __float_as_int(c), 0x114, 0xf, 0xf, false));
                    c *= __int_as_float(__builtin_amdgcn_update_dpp(0x3f800000, __float_as_int(c), 0x118, 0xf, 0xf, false));
                    c *= __int_as_float(__builtin_amdgcn_update_dpp(0x3f800000, __float_as_int(c), 0x142, 0xa, 0xf, false));
                    c *= __int_as_float(__builtin_amdgcn_update_dpp(0x3f800000, __float_as_int(c), 0x143, 0xc, 0xf, false));
                    const float cl = __int_as_float(__builtin_amdgcn_readlane(__float_as_int(c), 63));
                    const float r = fast_rcp(fmaxf(c, 1e-30f)), kv = 1.f - f;
                    const float qf = (j & 1) ? bf_hi(qa[j >> 1]) : bf_lo(qa[j >> 1]);
                    av[j] = qf * c; kp[j] = kv * r;
                    *(LAS bf16_t*)(KT + d * 144 + t * 2) = f2bf(kp[j] * cl);
                    const unsigned vb = (j & 1) ? (va[j >> 1] >> 16) : (va[j >> 1] & 0xffffu);
                    *(LAS bf16_t*)(VT + d * 144 + t * 2) = (bf16_t)vb;
                    if (lane == 0) { gam[d] = cl; if (PASS == 0) gseg[d] *= cl; }
                }
                u32x4 o1, o2; o1.x = pk2(av[0], av[1]); o1.y = pk2(av[2], av[3]); o1.z = pk2(av[4], av[5]); o1.w = pk2(av[6], av[7]);
                o2.x = pk2(kp[0], kp[1]); o2.y = pk2(kp[2], kp[3]); o2.z = pk2(kp[4], kp[5]); o2.w = pk2(kp[6], kp[7]);
                if (PASS == 1) { *(LAS u32x4*)(As + t * 272 + c8 * 16) = o1; *(LAS u32x4*)(Kp + t * 272 + c8 * 16) = o2; }
            }
            if (cc + 1 < HG_SEGC) {
#pragma unroll
                for (int i = 0; i < 2; ++i) {
                    const size_t go = (size_t)(tok0 + 64 + lane) * HW + h * HD + (w + 8 * i) * 8;
                    pq[i] = *(const u32x4*)(HQ + go); pf[i] = *(const u32x4*)(HF + go); pv[i] = *(const u32x4*)(HI + go);
                }
            }
            if (urow < NEXP) utab_quant_store(p, urow, lane, urv);
            if (cc + 1 < HG_SEGC && urow + 8 < NEXP) utab_load(p, urow + 8, lane, urv);
            __syncthreads();
            if (PASS == 1) {
                { const int tb = w >> 1;
#pragma unroll
                  for (int q = 0; q < 2; ++q) {
                      const int sb = (w & 1) * 2 + q;
                      f32x4 c = {0.f, 0.f, 0.f, 0.f};
#pragma unroll
                      for (int ks = 0; ks < 4; ++ks) {
                          const bf16x8 a = *(const LAS bf16x8*)(Kp + (sb * 16 + fr) * 272 + (ks * 32 + fq * 8) * 2);
                          const bf16x8 bb = *(const LAS bf16x8*)(As + (tb * 16 + fr) * 272 + (ks * 32 + fq * 8) * 2);
                          c = __builtin_amdgcn_mfma_f32_16x16x32_bf16(a, bb, c, 0, 0, 0);
                      }
                      const int t = tb * 16 + fr, s0 = sb * 16 + 4 * fq;
                      u32x2 v; v.x = pk2(s0 <= t ? c[0] : 0.f, s0 + 1 <= t ? c[1] : 0.f); v.y = pk2(s0 + 2 <= t ? c[2] : 0.f, s0 + 3 <= t ? c[3] : 0.f);
                      *(LAS u32x2*)(Ps + t * 144 + s0 * 2) = v;
                  } }
                __syncthreads();
                { const int tb = w >> 1, eh = w & 1;
                  f32x4 oc[4];
#pragma unroll
                  for (int q = 0; q < 4; ++q) oc[q] = (f32x4){0.f, 0.f, 0.f, 0.f};
#pragma unroll
                  for (int ks = 0; ks < 2; ++ks) {
                      const bf16x8 bb = *(const LAS bf16x8*)(Ps + (tb * 16 + fr) * 144 + (ks * 32 + fq * 8) * 2);
#pragma unroll
                      for (int q = 0; q < 4; ++q) {
                          const bf16x8 a = *(const LAS bf16x8*)(VT + ((eh * 4 + q) * 16 + fr) * 144 + (ks * 32 + fq * 8) * 2);
                          oc[q] = __builtin_amdgcn_mfma_f32_16x16x32_bf16(a, bb, oc[q], 0, 0, 0);
                      }
                  }
#pragma unroll
                  for (int ks = 0; ks < 4; ++ks) {
                      const bf16x8 bb = *(const LAS bf16x8*)(As + (tb * 16 + fr) * 272 + (ks * 32 + fq * 8) * 2);
#pragma unroll
                      for (int q = 0; q < 4; ++q) {
                          const bf16x8 a = *(const LAS bf16x8*)(ST + ((eh * 4 + q) * 16 + fr) * 272 + (ks * 32 + fq * 8) * 2);
                          oc[q] = __builtin_amdgcn_mfma_f32_16x16x32_bf16(a, bb, oc[q], 0, 0, 0);
                      }
                  }
                  float ss = 0.f;
#pragma unroll
                  for (int q = 0; q < 4; ++q) ss += (oc[q][0] * oc[q][0] + oc[q][1] * oc[q][1]) + (oc[q][2] * oc[q][2] + oc[q][3] * oc[q][3]);
                  ss += __shfl_xor(ss, 16); ss += __shfl_xor(ss, 32);
                  if (fq == 0) rs[eh * 64 + tb * 16 + fr] = ss;
                  __syncthreads();
                  const float tot = rs[tb * 16 + fr] + rs[64 + tb * 16 + fr];
                  const float rstd = rsqrtf(tot * (1.f / 128.f) + RMS_EPS);
                  const int tg = tok0 + tb * 16 + fr;
#pragma unroll
                  for (int q = 0; q < 4; ++q) {
                      const int e = (eh * 4 + q) * 16 + 4 * fq;
                      const f32x4 ng = ngv[q];
                      const u32x2 gg = ggv[q];
                      u32x2 v;
                      v.x = pk2(oc[q][0] * rstd * ng[0] * bf_lo(gg.x), oc[q][1] * rstd * ng[1] * bf_hi(gg.x));
                      v.y = pk2(oc[q][2] * rstd * ng[2] * bf_lo(gg.y), oc[q][3] * rstd * ng[3] * bf_hi(gg.y));
                      *(u32x2*)(BO + (size_t)tg * DM + h * HD + e) = v;
                  }
                }
            }
            { const f32x4 g4 = *(const LAS f32x4*)(gam + w * 16 + 4 * fq);
              bf16x8 a[2];
#pragma unroll
              for (int ks = 0; ks < 2; ++ks) a[ks] = *(const LAS bf16x8*)(KT + (w * 16 + fr) * 144 + (ks * 32 + fq * 8) * 2);
#pragma unroll
              for (int eb = 0; eb < 8; ++eb) {
                  f32x4 c = S[eb] * g4;
#pragma unroll
                  for (int ks = 0; ks < 2; ++ks) {
                      const bf16x8 bb = *(const LAS bf16x8*)(VT + (eb * 16 + fr) * 144 + (ks * 32 + fq * 8) * 2);
                      c = __builtin_amdgcn_mfma_f32_16x16x32_bf16(a[ks], bb, c, 0, 0, 0);
                  }
                  S[eb] = c;
              } }
            __syncthreads();
            if (PASS == 1) {
#pragma unroll
                for (int eb = 0; eb < 8; ++eb) { u32x2 v; v.x = pk2(S[eb][0], S[eb][1]); v.y = pk2(S[eb][2], S[eb][3]); *(LAS u32x2*)(ST + (eb * 16 + fr) * 272 + (w * 16 + 4 * fq) * 2) = v; }
            }
        }
        if (PASS == 0) {
            float* Ls = HST + (size_t)(bh * HG_NSEG + seg) * (HD * HD);
#pragma unroll
            for (int eb = 0; eb < 8; ++eb)
#pragma unroll
                for (int jj = 0; jj < 4; ++jj) Ls[(size_t)(w * 16 + 4 * fq + jj) * HD + eb * 16 + fr] = S[eb][jj];
            if (lane == 0) {
#pragma unroll
                for (int i = 0; i < 2; ++i)
#pragma unroll
                    for (int j = 0; j < 8; ++j) HGAM[(size_t)(bh * HG_NSEG + seg) * HD + (w + 8 * i) * 8 + j] = gseg[(w + 8 * i) * 8 + j];
            }
        }
    }
    __syncthreads();
}
__device__ __forceinline__ void phase_ln1(const Params& p, LAS unsigned char* lds, int wg, int G) {
    const int tid = opaque_tid(), w = tid >> 6, lane = tid & 63;
    const bf16_t* r1 = (const bf16_t*)(p.ws + WS_R1); const float* mod = (const float*)(p.ws + WS_MOD);
    unsigned char* h2q = p.ws + WS_H2; float* sh2 = (float*)(p.ws + WS_SH2); float* st = (float*)(p.ws + WS_STAT1);
    __syncthreads();
    { const int c_ = prm_col(tid); const f32x4 g_ = *(const f32x4*)(p.ln1_g + c_), b_ = *(const f32x4*)(p.ln1_b + c_);
#pragma unroll
      for (int bt = 0; bt < NB; ++bt) {
          const f32x4 sc_ = 1.f + *(const f32x4*)(mod + bt * 6 * DM + 4 * DM + c_), sh_ = *(const f32x4*)(mod + bt * 6 * DM + 3 * DM + c_);
          *(LAS f32x4*)(lds + (2 * bt) * 8192 + tid * 16) = g_ * sc_; *(LAS f32x4*)(lds + (2 * bt + 1) * 8192 + tid * 16) = b_ * sc_ + sh_;
      } }
    __syncthreads();
#pragma unroll 4
    for (int row = wg * 8 + w; row < NT; row += G * 8) {
        const int b = row / SEQ;
        f32x4 v[8]; float s = 0.f;
#pragma unroll
        for (int j = 0; j < 2; ++j)
#pragma unroll
            for (int q = 0; q < 2; ++q) { const u32x4 r = *(const u32x4*)(r1 + (size_t)row * DM + 1024 * j + 16 * lane + 8 * q);
                v[4 * j + 2 * q] = (f32x4){bf_lo(r.x), bf_hi(r.x), bf_lo(r.y), bf_hi(r.y)}; v[4 * j + 2 * q + 1] = (f32x4){bf_lo(r.z), bf_hi(r.z), bf_lo(r.w), bf_hi(r.w)};
                s += ((v[4 * j + 2 * q][0] + v[4 * j + 2 * q][1]) + (v[4 * j + 2 * q][2] + v[4 * j + 2 * q][3])) + ((v[4 * j + 2 * q + 1][0] + v[4 * j + 2 * q + 1][1]) + (v[4 * j + 2 * q + 1][2] + v[4 * j + 2 * q + 1][3])); }
        const float mean = wave_sum(s) * (1.f / DM);
        float s2 = 0.f;
#pragma unroll
        for (int i = 0; i < 8; ++i) { v[i] = v[i] - mean; s2 += (v[i][0] * v[i][0] + v[i][1] * v[i][1]) + (v[i][2] * v[i][2] + v[i][3] * v[i][3]); }
        const float rstd = rsqrtf(wave_sum(s2) * (1.f / DM) + LN_EPS);
        if (lane == 0) { st[row * 2] = mean; st[row * 2 + 1] = rstd; }
        float am = 0.f;
#pragma unroll
        for (int j = 0; j < 2; ++j)
#pragma unroll
            for (int q = 0; q < 4; ++q) {
                const int po = ((4 * j + q) * 64 + lane) * 16;
                const f32x4 gf = *(LAS const f32x4*)(lds + (2 * b) * 8192 + po), bf = *(LAS const f32x4*)(lds + (2 * b + 1) * 8192 + po);
                const f32x4 hh = v[4 * j + q] * rstd * gf + bf;
                v[4 * j + q] = hh;
                am = fmaxf(am, fmaxf(fmaxf(fabsf(hh[0]), fabsf(hh[1])), fmaxf(fabsf(hh[2]), fabsf(hh[3]))));
            }
        am = wave_max_nonneg(am);
        const float sc_ = am > 0.f ? am * (1.f / 127.f) : 1.f, inv = am > 0.f ? 127.f / am : 0.f;
        if (lane == 0) sh2[row] = sc_;
#pragma unroll
        for (int j = 0; j < 2; ++j) {
            unsigned wd[4];
#pragma unroll
            for (int q = 0; q < 4; ++q) { unsigned x4 = 0;
#pragma unroll
                for (int e = 0; e < 4; ++e) { const int qi = (int)rintf(v[4 * j + q][e] * inv); x4 |= ((unsigned)qi & 0xffu) << (8 * e); }
                wd[q] = x4; }
            *(u32x4*)(h2q + (size_t)row * DM + 1024 * j + 16 * lane) = (u32x4){wd[0], wd[1], wd[2], wd[3]};
        }
    }
}

__device__ __forceinline__ unsigned f2ord(float f) { const unsigned u = __float_as_uint(f); return (u & 0x80000000u) ? ~u : (u | 0x80000000u); }
__device__ __forceinline__ unsigned wave_max_u32(unsigned v) {
#pragma unroll
    for (int o = 1; o < 64; o <<= 1) { const unsigned t = (unsigned)__shfl_xor((int)v, o); v = t > v ? t : v; }
    return v;
}
constexpr int RT_OFF_TBL = 65536, RT_LDS_END = RT_OFF_TBL + 8 * 8192;
__device__ __forceinline__ void ins16(float (&L)[16], float x) {
#pragma unroll
    for (int i = 15; i >= 1; --i) L[i] = __builtin_amdgcn_fmed3f(L[i - 1], L[i], x);
    L[0] = fmaxf(L[0], x);
}
__device__ __forceinline__ void phase_route(const Params& p, LAS unsigned char* lds, int wg, int G, int only_h = -1, int only_tb = 0) {
    const int tid = opaque_tid(), w = __builtin_amdgcn_readfirstlane(tid >> 6), lane = tid & 63, l31 = lane & 31, h2 = lane >> 5;
    const bf16_t* QP = (const bf16_t*)(p.ws + WS_QP); const bf16_t* SK = (const bf16_t*)(p.ws + WS_SKB);
    int* RIDX = (int*)(p.ws + WS_RIDX); float* RGATE = (float*)(p.ws + WS_RGATE); float* RUS = (float*)(p.ws + WS_RUS);
    const float* USC = (const float*)(p.ws + WS_USC); const float* VSC = (const float*)(p.ws + WS_VSC);
    LAS float* tbl = (LAS float*)(lds + RT_OFF_TBL + w * 8192);
    for (int item = (only_h >= 0 ? 0 : wg); item < (only_h >= 0 ? 1 : PH * (NT / 256)); item += G) {
        const int h = only_h >= 0 ? only_h : item / (NT / 256), tb = only_h >= 0 ? only_tb : item % (NT / 256);
        __syncthreads();
#pragma unroll
        for (int i = 0; i < 8; ++i) {
            const int id = tid + i * NTHR, row = id >> 4, c16 = id & 15;
            *(LAS u32x4*)(lds + row * 256 + ((c16 ^ (row & 15)) << 4)) = *(const u32x4*)(SK + ((size_t)h * 256 + row) * 128 + c16 * 8);
        }
        __syncthreads();
        const int t = tb * 256 + w * 32 + l31;
#pragma unroll 1
        for (int pp = 0; pp < 2; ++pp) {
            bf16x8 qf[8];
            { const bf16_t* qrow = QP + (size_t)t * DM + h * 256 + pp * 128 + h2 * 8;
#pragma unroll
              for (int ks = 0; ks < 8; ++ks) qf[ks] = *(const bf16x8*)(qrow + ks * 16); }
            float L[16];
#pragma unroll
            for (int i = 0; i < 16; ++i) L[i] = -INFINITY;
#pragma unroll 1
            for (int nb = 0; nb < 4; ++nb) {
                f32x16 S;
#pragma unroll
                for (int r = 0; r < 16; ++r) S[r] = 0.f;
                const int row = pp * 128 + nb * 32 + l31;
#pragma unroll
                for (int ks = 0; ks < 8; ++ks) {
                    const bf16x8 a = *(const LAS bf16x8*)(lds + row * 256 + (((ks * 2 + h2) ^ (row & 15)) << 4));
                    S = __builtin_amdgcn_mfma_f32_32x32x16_bf16(a, qf[ks], S, 0, 0, 0);
                }
#pragma unroll
                for (int r = 0; r < 16; ++r) {
                    const unsigned n = (unsigned)(nb * 32 + (r & 3) + 8 * (r >> 2) + 4 * h2);
                    ins16(L, __uint_as_float((__float_as_uint(S[r]) & ~127u) | n));
                }
            }
            float P[16];
#pragma unroll
            for (int i = 0; i < 16; ++i) P[i] = __shfl_xor(L[i], 32);
#pragma unroll
            for (int i = 0; i < 16; ++i) ins16(L, P[i]);
#pragma unroll
            for (int i = 0; i < 16; ++i) tbl[(pp * 16 + i) * 64 + lane] = L[i];
        }
        float L0[16], L1[16];
#pragma unroll
        for (int i = 0; i < 16; ++i) { L0[i] = tbl[i * 64 + lane]; L1[i] = tbl[(16 + i) * 64 + lane]; }
        float C[16];
#pragma unroll
        for (int i = 0; i < 16; ++i) C[i] = -INFINITY;
#pragma unroll
        for (int a = 0; a < 16; ++a)
#pragma unroll
            for (int b = 0; b < 16; ++b)
                if ((a + 1) * (b + 1) <= 16) ins16(C, __uint_as_float((__float_as_uint(L0[a] + L1[b]) & ~255u) | (unsigned)(a * 16 + b)));
        const float vmax = C[0];
        float den = 0.f, ex[16];
#pragma unroll
        for (int i = 0; i < 16; ++i) { ex[i] = __expf(C[i] - vmax); den += ex[i]; }
        const float rden = 1.f / den;
        int* ip = RIDX + (size_t)t * 128 + h * 16 + h2 * 8; float* gp = RGATE + (size_t)t * 128 + h * 16 + h2 * 8; float* up = RUS + (size_t)t * 128 + h * 16 + h2 * 8;
        int eo[16]; float go[16], uo[16];
#pragma unroll
        for (int j = 0; j < 16; ++j) {
            const unsigned cb = __float_as_uint(C[j]), a = (cb >> 4) & 15u, b = cb & 15u;
            const unsigned i0 = __float_as_uint(tbl[a * 64 + lane]) & 127u, i1 = __float_as_uint(tbl[(16 + b) * 64 + lane]) & 127u;
            eo[j] = (int)(i0 * NKEYS + i1);
        }
#pragma unroll
        for (int j = 0; j < 16; ++j) { go[j] = ex[j] * rden * VSC[eo[j]]; uo[j] = USC[eo[j]]; }
        if (h2 == 0) {
            *(int4*)ip = make_int4(eo[0], eo[1], eo[2], eo[3]); *(int4*)(ip + 4) = make_int4(eo[4], eo[5], eo[6], eo[7]);
            *(f32x4*)gp = (f32x4){go[0], go[1], go[2], go[3]}; *(f32x4*)(gp + 4) = (f32x4){go[4], go[5], go[6], go[7]};
            *(f32x4*)up = (f32x4){uo[0], uo[1], uo[2], uo[3]}; *(f32x4*)(up + 4) = (f32x4){uo[4], uo[5], uo[6], uo[7]};
        } else {
            *(int4*)ip = make_int4(eo[8], eo[9], eo[10], eo[11]); *(int4*)(ip + 4) = make_int4(eo[12], eo[13], eo[14], eo[15]);
            *(f32x4*)gp = (f32x4){go[8], go[9], go[10], go[11]}; *(f32x4*)(gp + 4) = (f32x4){go[12], go[13], go[14], go[15]};
            *(f32x4*)up = (f32x4){uo[8], uo[9], uo[10], uo[11]}; *(f32x4*)(up + 4) = (f32x4){uo[12], uo[13], uo[14], uo[15]};
        }
    }
    __syncthreads();
}

__device__ __forceinline__ float gelu_exact(float v) { return 0.5f * v * (1.f + erff(v * 0.70710678118654752f)); }
__device__ __forceinline__ float ub0(unsigned w) { return (float)(w & 0xffu); }
__device__ __forceinline__ float ub1(unsigned w) { return (float)((w >> 8) & 0xffu); }
__device__ __forceinline__ float ub2(unsigned w) { return (float)((w >> 16) & 0xffu); }
__device__ __forceinline__ float ub3(unsigned w) { return (float)(w >> 24); }
#if U_FP6
constexpr int PE_OFF_XQ = 0, PE_OFF_KEYS = 131072, PE_OFF_XS = 147456, PE_OFF_WT = 0, PE_OFF_PW = 16384, PE_LDS_END = PE_OFF_XS + 256;
#else
constexpr int PE_OFF_XQ = 0, PE_OFF_KEYS = 65536, PE_OFF_WT = 81920, PE_OFF_PW = 98304, PE_OFF_XS = 114688, PE_LDS_END = PE_OFF_XS + 256;
#endif
#ifndef PE_VBT
#define PE_VBT 8
#endif
constexpr int PE_VB = 16;
__device__ __forceinline__ void peer_axpy(f32x2 (&a)[16], float wgt, const u32x4 (&v)[2]) {
    const f32x2 w2 = {wgt, wgt};
#pragma unroll
    for (int j = 0; j < 2; ++j) {
        const unsigned r[4] = {v[j].x, v[j].y, v[j].z, v[j].w};
#pragma unroll
        for (int q = 0; q < 4; ++q) {
            a[8 * j + 2 * q] += w2 * __builtin_amdgcn_cvt_pk_f32_fp8((int)r[q], false);
            a[8 * j + 2 * q + 1] += w2 * __builtin_amdgcn_cvt_pk_f32_fp8((int)r[q], true);
        }
    }
}
__device__ __forceinline__ void peer_axpy6(f32x2 (&a)[16], float wgt, const u32x4& va, const u32x2& vb) {
    const f32x2 w2 = {wgt, wgt};
    const u32x6v pk = {va.x, va.y, va.z, va.w, vb.x, vb.y};
    const f32x32v y = __builtin_amdgcn_cvt_scalef32_pk32_f32_fp6(pk, 1.0f);
#pragma unroll
    for (int i = 0; i < 16; ++i) a[i] += w2 * (f32x2){y[2 * i], y[2 * i + 1]};
}
__device__ __forceinline__ void peer_axpy4(f32x2 (&a)[16], float wgt, const u32x4& va) {
    const f32x2 w2 = {wgt, wgt};
    const unsigned r[4] = {va.x, va.y, va.z, va.w};
#pragma unroll
    for (int q = 0; q < 4; ++q) {
        a[4 * q + 0] += w2 * __builtin_amdgcn_cvt_scalef32_pk_f32_fp4(r[q], 1.0f, 0);
        a[4 * q + 1] += w2 * __builtin_amdgcn_cvt_scalef32_pk_f32_fp4(r[q], 1.0f, 1);
        a[4 * q + 2] += w2 * __builtin_amdgcn_cvt_scalef32_pk_f32_fp4(r[q], 1.0f, 2);
        a[4 * q + 3] += w2 * __builtin_amdgcn_cvt_scalef32_pk_f32_fp4(r[q], 1.0f, 3);
    }
}
constexpr int PE_OFF_PRM = 0;
static_assert(U_FP6 == 0, "the parameter stage reuses the int8 x-row region; the fp6-u layout puts the weight table there");
__device__ __forceinline__ void peer_ln2_store(const Params& p, LAS const unsigned char* prm, f32x2 (&acc2)[16], int t, int lane_in) {
    int lane = lane_in; asm volatile("" : "+v"(lane));
    const bf16_t* r1 = (const bf16_t*)(p.ws + WS_R1); const float* st = (const float*)(p.ws + WS_STAT1); const float* mod = (const float*)(p.ws + WS_MOD);
    const int b = t / SEQ;
    float acc[32];
#pragma unroll
    for (int i = 0; i < 16; ++i) { acc[2 * i] = acc2[i].x; acc[2 * i + 1] = acc2[i].y; }
    const float mean1 = st[t * 2], rstd1 = st[t * 2 + 1];
    float s = 0.f;
#pragma unroll
    for (int j = 0; j < 2; ++j)
#pragma unroll
        for (int q = 0; q < 4; ++q) {
            const int c = 1024 * j + 16 * lane + 4 * q;
            const u32x2 rb = *(const u32x2*)(r1 + (size_t)t * DM + c); const f32x4 rv = {bf_lo(rb.x), bf_hi(rb.x), bf_lo(rb.y), bf_hi(rb.y)};
            const int po = ((4 * j + q) * 64 + lane) * 16;
            const f32x4 g = *(LAS const f32x4*)(prm + po), bb = *(LAS const f32x4*)(prm + 8192 + po), g2 = *(LAS const f32x4*)(prm + 16384 + po);
#pragma unroll
            for (int k = 0; k < 4; ++k) {
                const float val = (rv[k] - mean1) * rstd1 * g[k] + bb[k] + g2[k] * acc[16 * j + 4 * q + k];
                acc[16 * j + 4 * q + k] = val; s += val;
            }
            asm volatile("" ::: "memory");
        }
    const float mean = wave_sum(s) * (1.f / DM);
    float s2 = 0.f;
#pragma unroll
    for (int i = 0; i < 32; ++i) { acc[i] -= mean; s2 += acc[i] * acc[i]; }
    const float rstd = rsqrtf(wave_sum(s2) * (1.f / DM) + LN_EPS);
#pragma unroll
    for (int j = 0; j < 2; ++j)
#pragma unroll
        for (int q = 0; q < 4; ++q) {
            const int c = 1024 * j + 16 * lane + 4 * q;
            const int po = ((4 * j + q) * 64 + lane) * 16;
            const f32x4 g = *(LAS const f32x4*)(prm + 24576 + po), bb = *(LAS const f32x4*)(prm + 32768 + po);
            f32x4 o;
#pragma unroll
            for (int k = 0; k < 4; ++k) o[k] = acc[16 * j + 4 * q + k] * rstd * g[k] + bb[k];
            *(f32x4*)(p.out + (size_t)t * DM + c) = o;
            asm volatile("" ::: "memory");
        }
}
__device__ __forceinline__ void phase_peer(const Params& p, LAS unsigned char* lds, int wg, int G) {
    const int tid = opaque_tid(), w = __builtin_amdgcn_readfirstlane(tid >> 6), lane = tid & 63;
    const unsigned char* UQ = p.ws + WS_UQ; const unsigned char* VQ = p.ws + WS_VQ;
    const int* RIDX = (const int*)(p.ws + WS_RIDX); const float* RGATE = (const float*)(p.ws + WS_RGATE); const float* RUS = (const float*)(p.ws + WS_RUS);
    LAS unsigned char* XQ = lds + PE_OFF_XQ; LAS unsigned* KEYS = (LAS unsigned*)(lds + PE_OFF_KEYS); LAS float* WT = (LAS float*)(lds + PE_OFF_WT);
    LAS unsigned* PW = (LAS unsigned*)(lds + PE_OFF_PW) + w * 512; LAS float* XS = (LAS float*)(lds + PE_OFF_XS);
    for (int item = wg; item < NT / 32; item += G) {
        const int t0 = item * 32;
        __syncthreads();
#pragma unroll
        for (int k = 0; k < 4; ++k) {
            const int tl = 4 * w + k;
            const unsigned char* src = (p.ws + WS_H2) + (size_t)(t0 + tl) * DM + 16 * lane;
#if U_FP6
            {
                const u32x4 s0 = *(const u32x4*)src, s1 = *(const u32x4*)(src + 1024);
#pragma unroll
                for (int hlf = 0; hlf < 2; ++hlf) {
                    const u32x4 sv = hlf ? s1 : s0; unsigned o[8];
#pragma unroll
                    for (int q = 0; q < 4; ++q) {
                        const unsigned uw = sv[q] ^ 0x80808080u;
                        const f16x2v lo = {(_Float16)(ub0(uw) - 128.f), (_Float16)(ub1(uw) - 128.f)};
                        const f16x2v hi = {(_Float16)(ub2(uw) - 128.f), (_Float16)(ub3(uw) - 128.f)};
                        o[2 * q] = __builtin_bit_cast(unsigned, lo); o[2 * q + 1] = __builtin_bit_cast(unsigned, hi);
                    }
                    LAS unsigned char* xd = XQ + tl * 4096 + 2048 * hlf + 32 * lane;
                    *(LAS u32x4*)xd = (u32x4){o[0], o[1], o[2], o[3]}; *(LAS u32x4*)(xd + 16) = (u32x4){o[4], o[5], o[6], o[7]};
                }
            }
#else
            *(LAS u32x4*)(XQ + tl * DM + 16 * lane) = *(const u32x4*)src; *(LAS u32x4*)(XQ + tl * DM + 1024 + 16 * lane) = *(const u32x4*)(src + 1024);
#endif
            if (lane == 0) XS[tl] = ((const float*)(p.ws + WS_SH2))[t0 + tl];
        }
#pragma unroll
        for (int k = 0; k < 8; ++k) { const int idx = tid + NTHR * k; KEYS[idx] = ((unsigned)RIDX[(size_t)t0 * 128 + idx] << 12) | (unsigned)idx; }
        __syncthreads();
        for (int k = 2; k <= 4096; k <<= 1)
            for (int j = k >> 1; j > 0; j >>= 1) {
#pragma unroll
                for (int qq = 0; qq < 4; ++qq) {
                    const int q = w * 256 + qq * 64 + lane, lo = ((q & ~(j - 1)) << 1) | (q & (j - 1)), hi = lo | j;
                    const unsigned a = KEYS[lo], b = KEYS[hi];
                    const bool up = (lo & k) == 0;
                    if ((a > b) == up) { KEYS[lo] = b; KEYS[hi] = a; }
                }
                if (j >= 512 || (j == 1 && k >= 512)) __syncthreads();
                else asm volatile("s_waitcnt lgkmcnt(0)" ::: "memory");
            }
        __syncthreads();
#if U_FP6
        float wreg[8];
#pragma unroll
        for (int j = 0; j < 8; ++j) wreg[j] = 0.f;
#pragma unroll 1
        for (int g = 0; g < 8; ++g) {
            int lane_u = lane; asm volatile("" : "+v"(lane_u));
            const unsigned mykey = KEYS[g * 512 + lane_u * 8 + w];
            const int e_l = (int)(mykey >> 12), ts_l = (int)(mykey & 4095u), tl_l = ts_l >> 7;
            float v0[64];
#pragma unroll
            for (int k = 0; k < 64; ++k) {
                const int ek = __builtin_amdgcn_readlane(e_l, k), tlk = __builtin_amdgcn_readlane(tl_l, k);
                const unsigned char* ur = UQ + (size_t)ek * UROW;
                const u32x4 u0 = *(const u32x4*)(ur + 16 * lane_u); const u32x2 u1 = *(const u32x2*)(ur + 1024 + 8 * lane_u);
                const LAS unsigned char* xr = XQ + tlk * 4096 + 32 * lane_u;
                const u32x4 x0 = *(const LAS u32x4*)xr, x1 = *(const LAS u32x4*)(xr + 16), x2 = *(const LAS u32x4*)(xr + 2048), x3 = *(const LAS u32x4*)(xr + 2048 + 16);
                const u32x6v pk = {u0.x, u0.y, u0.z, u0.w, u1.x, u1.y};
                const f16x32v y = __builtin_amdgcn_cvt_scalef32_pk32_f16_fp6(pk, 1.0f);
                const f16x8v h0 = __builtin_bit_cast(f16x8v, x0), h1 = __builtin_bit_cast(f16x8v, x1), h2 = __builtin_bit_cast(f16x8v, x2), h3 = __builtin_bit_cast(f16x8v, x3);
                float d = 0.f;
#pragma unroll
                for (int i = 0; i < 4; ++i) {
                    d = __builtin_amdgcn_fdot2((f16x2v){y[2 * i], y[2 * i + 1]}, (f16x2v){h0[2 * i], h0[2 * i + 1]}, d, false);
                    d = __builtin_amdgcn_fdot2((f16x2v){y[8 + 2 * i], y[8 + 2 * i + 1]}, (f16x2v){h1[2 * i], h1[2 * i + 1]}, d, false);
                    d = __builtin_amdgcn_fdot2((f16x2v){y[16 + 2 * i], y[16 + 2 * i + 1]}, (f16x2v){h2[2 * i], h2[2 * i + 1]}, d, false);
                    d = __builtin_amdgcn_fdot2((f16x2v){y[24 + 2 * i], y[24 + 2 * i + 1]}, (f16x2v){h3[2 * i], h3[2 * i + 1]}, d, false);
                }
                v0[k] = d;
            }
            float v1[32], v2[16], v3[8], v4[4], v5[2];
            { const bool bt = lane & 1;
#pragma unroll
              for (int i = 0; i < 32; ++i) { const float keep = bt ? v0[2 * i + 1] : v0[2 * i], send = bt ? v0[2 * i] : v0[2 * i + 1]; v1[i] = keep + __shfl_xor(send, 1); } }
            { const bool bt = lane & 2;
#pragma unroll
              for (int i = 0; i < 16; ++i) { const float keep = bt ? v1[2 * i + 1] : v1[2 * i], send = bt ? v1[2 * i] : v1[2 * i + 1]; v2[i] = keep + __shfl_xor(send, 2); } }
            { const bool bt = lane & 4;
#pragma unroll
              for (int i = 0; i < 8; ++i) { const float keep = bt ? v2[2 * i + 1] : v2[2 * i], send = bt ? v2[2 * i] : v2[2 * i + 1]; v3[i] = keep + __shfl_xor(send, 4); } }
            { const bool bt = lane & 8;
#pragma unroll
              for (int i = 0; i < 4; ++i) { const float keep = bt ? v3[2 * i + 1] : v3[2 * i], send = bt ? v3[2 * i] : v3[2 * i + 1]; v4[i] = keep + __shfl_xor(send, 8); } }
            { const bool bt = lane & 16;
#pragma unroll
              for (int i = 0; i < 2; ++i) { const float keep = bt ? v4[2 * i + 1] : v4[2 * i], send = bt ? v4[2 * i] : v4[2 * i + 1]; v5[i] = keep + __shfl_xor(send, 16); } }
            float tot;
            { const bool bt = lane & 32; const float keep = bt ? v5[1] : v5[0], send = bt ? v5[0] : v5[1]; tot = keep + __shfl_xor(send, 32); }
            const size_t eo = (size_t)t0 * 128 + ts_l;
            const float act = RUS[eo] * XS[tl_l] * tot;
            const float wv = RGATE[eo] * gelu_exact(act);
#pragma unroll
            for (int j = 0; j < 8; ++j) wreg[j] = (g == j) ? wv : wreg[j];
        }
        __syncthreads();
#pragma unroll
        for (int j = 0; j < 8; ++j) { const unsigned key = KEYS[j * 512 + lane * 8 + w]; WT[key & 4095u] = wreg[j]; }
        __syncthreads();
#else
#ifndef PEER_REP_U
#define PEER_REP_U 1
#endif
#pragma unroll 1
        for (int g = 0; g < 8 * PEER_REP_U; ++g) {
            int lane_u = lane; asm volatile("" : "+v"(lane_u));
            const unsigned mykey = KEYS[(g & 7) * 512 + lane_u * 8 + w];
            const int e_l = (int)(mykey >> 12), ts_l = (int)(mykey & 4095u), tl_l = ts_l >> 7;
            const size_t eo = (size_t)t0 * 128 + ts_l;
            const float rus_l = RUS[eo], rgate_l = RGATE[eo];
            int v0[64];
#pragma unroll
            for (int k = 0; k < 64; ++k) {
                const int ek = __builtin_amdgcn_readlane(e_l, k), tlk = __builtin_amdgcn_readlane(tl_l, k);
                const unsigned char* ur = UQ + (size_t)ek * DM + 16 * lane_u;
                const u32x4 u0 = *(const u32x4*)ur, u1 = *(const u32x4*)(ur + 1024);
                const LAS unsigned char* xr = XQ + tlk * DM + 16 * lane_u;
                const u32x4 x0 = *(const LAS u32x4*)xr, x1 = *(const LAS u32x4*)(xr + 1024);
                int d = 0;
                d = __builtin_amdgcn_sdot4((int)u0.x, (int)x0.x, d, false); d = __builtin_amdgcn_sdot4((int)u0.y, (int)x0.y, d, false);
                d = __builtin_amdgcn_sdot4((int)u0.z, (int)x0.z, d, false); d = __builtin_amdgcn_sdot4((int)u0.w, (int)x0.w, d, false);
                d = __builtin_amdgcn_sdot4((int)u1.x, (int)x1.x, d, false); d = __builtin_amdgcn_sdot4((int)u1.y, (int)x1.y, d, false);
                d = __builtin_amdgcn_sdot4((int)u1.z, (int)x1.z, d, false); d = __builtin_amdgcn_sdot4((int)u1.w, (int)x1.w, d, false);
                v0[k] = d;
            }
            int v1[32], v2[16], v3[8], v4[4], v5[2];
            { const bool bt = lane & 1;
#pragma unroll
              for (int i = 0; i < 32; ++i) { const int keep = bt ? v0[2 * i + 1] : v0[2 * i], send = bt ? v0[2 * i] : v0[2 * i + 1]; v1[i] = keep + __shfl_xor(send, 1); } }
            { const bool bt = lane & 2;
#pragma unroll
              for (int i = 0; i < 16; ++i) { const int keep = bt ? v1[2 * i + 1] : v1[2 * i], send = bt ? v1[2 * i] : v1[2 * i + 1]; v2[i] = keep + __shfl_xor(send, 2); } }
            { const bool bt = lane & 4;
#pragma unroll
              for (int i = 0; i < 8; ++i) { const int keep = bt ? v2[2 * i + 1] : v2[2 * i], send = bt ? v2[2 * i] : v2[2 * i + 1]; v3[i] = keep + __shfl_xor(send, 4); } }
            { const bool bt = lane & 8;
#pragma unroll
              for (int i = 0; i < 4; ++i) { const int keep = bt ? v3[2 * i + 1] : v3[2 * i], send = bt ? v3[2 * i] : v3[2 * i + 1]; v4[i] = keep + __shfl_xor(send, 8); } }
            { const bool bt = lane & 16;
#pragma unroll
              for (int i = 0; i < 2; ++i) { const int keep = bt ? v4[2 * i + 1] : v4[2 * i], send = bt ? v4[2 * i] : v4[2 * i + 1]; v5[i] = keep + __shfl_xor(send, 16); } }
            int tot;
            { const bool bt = lane & 32; const int keep = bt ? v5[1] : v5[0], send = bt ? v5[0] : v5[1]; tot = keep + __shfl_xor(send, 32); }
            const float act = rus_l * XS[tl_l] * (float)tot;
            WT[ts_l] = rgate_l * gelu_exact(act);
        }
        __syncthreads();
#endif
        { const int j_ = tid >> 8, q_ = (tid >> 6) & 3, l_ = tid & 63, c_ = 1024 * j_ + 16 * l_ + 4 * q_, b_ = t0 / SEQ;
          const f32x4 g1 = *(const f32x4*)(p.ln1_g + c_), b1 = *(const f32x4*)(p.ln1_b + c_), gg = *(const f32x4*)((const float*)(p.ws + WS_MOD) + b_ * 6 * DM + 5 * DM + c_);
          LAS unsigned char* pd = lds + PE_OFF_PRM + tid * 16;
          *(LAS f32x4*)pd = g1 * ALPHA; *(LAS f32x4*)(pd + 8192) = b1 * ALPHA; *(LAS f32x4*)(pd + 16384) = gg + 1.f;
          *(LAS f32x4*)(pd + 24576) = *(const f32x4*)(p.ln2_g + c_); *(LAS f32x4*)(pd + 32768) = *(const f32x4*)(p.ln2_b + c_); }
        __syncthreads();
        { int b0 = 0, b1 = 128, b2 = 256, b3 = 384;
#pragma unroll 1
          for (int c = 0; c < 64; ++c) {
              const unsigned key = KEYS[c * 64 + lane];
              const bool mine = ((key >> 9) & 7u) == (unsigned)w; const unsigned j = (key >> 7) & 3u;
              const unsigned long long m0 = __ballot(mine && j == 0), m1 = __ballot(mine && j == 1), m2 = __ballot(mine && j == 2), m3 = __ballot(mine && j == 3), lt = (1ull << lane) - 1ull;
              if (mine && j == 0) PW[b0 + __popcll(m0 & lt)] = key;
              if (mine && j == 1) PW[b1 + __popcll(m1 & lt)] = key;
              if (mine && j == 2) PW[b2 + __popcll(m2 & lt)] = key;
              if (mine && j == 3) PW[b3 + __popcll(m3 & lt)] = key;
              b0 += __popcll(m0); b1 += __popcll(m1); b2 += __popcll(m2); b3 += __popcll(m3);
          } }
#pragma unroll 1
        for (int half = 0; half < 2; ++half) {
            int lane_v = lane; asm volatile("" : "+v"(lane_v));
            f32x2 a0[16], a1[16];
#pragma unroll
            for (int i = 0; i < 16; ++i) { a0[i] = (f32x2){0.f, 0.f}; a1[i] = (f32x2){0.f, 0.f}; }
#pragma unroll 1
            for (int i0 = 0; i0 < 128; i0 += PE_VBT) {
                u32x4 va[PE_VBT], vb[PE_VBT]; float wa[PE_VBT], wb[PE_VBT];
#pragma unroll
                for (int q = 0; q < PE_VBT; ++q) {
                    const unsigned ka = (unsigned)__builtin_amdgcn_readfirstlane((int)PW[(2 * half) * 128 + i0 + q]);
                    const unsigned kb = (unsigned)__builtin_amdgcn_readfirstlane((int)PW[(2 * half + 1) * 128 + i0 + q]);
                    va[q] = *(const u32x4*)(VQ + (size_t)(ka >> 12) * VROW + 16 * lane_v);
                    vb[q] = *(const u32x4*)(VQ + (size_t)(kb >> 12) * VROW + 16 * lane_v);
                    wa[q] = __int_as_float(__builtin_amdgcn_readfirstlane(__float_as_int(WT[ka & 4095u])));
                    wb[q] = __int_as_float(__builtin_amdgcn_readfirstlane(__float_as_int(WT[kb & 4095u])));
                }
#pragma unroll
                for (int q = 0; q < PE_VBT; ++q) { peer_axpy4(a0, wa[q], va[q]); peer_axpy4(a1, wb[q], vb[q]); }
            }
            peer_ln2_store(p, lds + PE_OFF_PRM, a0, t0 + 4 * w + 2 * half + 0, lane_v);
            peer_ln2_store(p, lds + PE_OFF_PRM, a1, t0 + 4 * w + 2 * half + 1, lane_v);
        }
    }
    __syncthreads();
}
constexpr int LDS_BAR_OFF = 153600, LDS_BYTES = LDS_BAR_OFF + 64;
static_assert(HG_LDS_END <= LDS_BAR_OFF && PE_LDS_END <= LDS_BAR_OFF && RT_LDS_END <= LDS_BAR_OFF && pg8::STAGE_BYTES + pg8::SCALE_BYTES <= LDS_BAR_OFF, "LDS map");
constexpr int N_PHASES = 11;
extern __shared__ __attribute__((aligned(16))) unsigned char smem_raw[];

template <int PH>
__device__ __forceinline__ void run_phase(const Params& p, LAS unsigned char* lds, int wg, int G) {
    if constexpr (PH == 0) { phase_ada(p, lds, wg, G); phase_conv(p, lds, wg, G); }
    if constexpr (PH == 1) { phase_hmod(p, lds, wg, G); }
    if constexpr (PH == 2) { pg8::StaticOrder S; S.init(NT, DIN, G, wg); pg8::Gemm g{(const bf16_t*)(p.ws + WS_HBF), (const bf16_t*)(p.ws + WS_WQ8), NT, DIN, DM / 2}; EpiProj E{p.ws};
        const int rem = S.nwg % G; const bool shortwg = rem != 0 && wg >= rem, first = shortwg && ((wg >> 3) & 1);
        if (first) phase_vtab(p, wg - rem, G - rem);
        pg8::gemm_phase(lds, g, S, E);
        if (rem == 0) phase_vtab(p, wg, G); else if (shortwg && !first) phase_vtab(p, wg - rem, G - rem); }
    if constexpr (PH == 3) { phase_hgrn<0>(p, lds, wg, G); }
    if constexpr (PH == 4) { phase_attn(p, lds, wg, G); phase_hgrn<1>(p, lds, wg, G); }
    if constexpr (PH == 5) { pg8::StaticOrder S; S.init(NT, DM, G, wg); pg8::Gemm g{(const bf16_t*)(p.ws + WS_AB), (const bf16_t*)(p.ws + WS_WAT), NT, DM, DM}; EpiMerge2 E{p.ws}; pg8::gemm_phase(lds, g, S, E); }
    if constexpr (PH == 6) { pg8::StaticOrder S; S.init(NT, DM, G, wg); pg8::Gemm g{(const bf16_t*)(p.ws + WS_MERGED), (const bf16_t*)(p.ws + WS_WOT), NT, DM, DM}; EpiRes1 E{p.ws, p.x}; pg8::gemm_phase(lds, g, S, E); }
    if constexpr (PH == 7) { phase_ln1(p, lds, wg, G); }
    if constexpr (PH == 8) { pg8::StaticOrder S; S.init(NT, DM, G, wg); pg8::Gemm g{(const bf16_t*)(p.ws + WS_H2), (const bf16_t*)(p.ws + WS_WQ8B), NT, DM, DM / 2}; EpiQP8 E{p.ws}; pg8::gemm_phase(lds, g, S, E);
        asm volatile("s_waitcnt vmcnt(0)" ::: "memory"); __syncthreads();
        pg8::Unit u; for (int i = 0; S.next(i, u); ++i) phase_route(p, lds, wg, G, u.pn, u.pm); }
    if constexpr (PH == 9) { }
    if constexpr (PH == 10) { phase_peer(p, lds, wg, G); }
}

#ifndef N_LAUNCH_MODE
#define N_LAUNCH_MODE 1
#endif
struct KArgs { Params p; int ph_lo, ph_hi; };

__global__ void __launch_bounds__(NTHR, 2) k_fwd(KArgs a) {
#if N_LAUNCH_MODE == 1
    constexpr int PH_LO = 0, PH_HI = N_PHASES;
#else
    const int PH_LO = a.ph_lo, PH_HI = a.ph_hi;
#endif
    LAS unsigned char* lds = (LAS unsigned char*)smem_raw;
    const int wg = blockIdx.x, G = gridDim.x;
    volatile LAS unsigned* st = (volatile LAS unsigned*)(lds + LDS_BAR_OFF);
    XcdBarrier xb; xb.bar = (unsigned*)(a.p.ws + WS_BAR); xb.x = 0; xb.st = st;
    if (PH_HI - PH_LO > 1) {
        if (threadIdx.x == 0) { st[0] = 0; st[1] = 0; st[2] = 0; st[3] = 0; }
        __syncthreads();
        xb = xcd_barrier_post((unsigned*)(a.p.ws + WS_BAR), st);
    }
#ifndef DOUBLE_MASK
#define DOUBLE_MASK 0
#endif
#define OPAQUE_WS(Q) { unsigned long long u_ = (unsigned long long)(Q).ws; asm volatile("" : "+s"(u_)); (Q).ws = (unsigned char*)(__attribute__((address_space(1))) unsigned char*)u_; }
#define RUN_PHASE(PH) if (PH_LO <= PH && PH < PH_HI) { Params q = a.p; OPAQUE_WS(q); run_phase<PH>(q, lds, wg, G); \
        if ((DOUBLE_MASK >> PH) & 1) { xcd_barrier(xb); OPAQUE_WS(q); run_phase<PH>(q, lds, wg, G); } \
        if (PH + 1 < PH_HI) xcd_barrier(xb); }
    RUN_PHASE(0) RUN_PHASE(1) RUN_PHASE(2)
#if (DOUBLE_MASK & 0x18) == 0
    if (PH_LO <= 3 && 4 < PH_HI) {
        { Params q = a.p; OPAQUE_WS(q); run_phase<3>(q, lds, wg, G); }
        xcd_barrier_arrive(xb);
        { Params q = a.p; OPAQUE_WS(q); phase_attn(q, lds, wg, G); }
        xcd_barrier_wait(xb);
        { Params q = a.p; OPAQUE_WS(q); phase_hgrn<1>(q, lds, wg, G); }
        if (5 < PH_HI) xcd_barrier(xb);
    } else { RUN_PHASE(3) RUN_PHASE(4) }
#else
    RUN_PHASE(3) RUN_PHASE(4)
#endif
    RUN_PHASE(5) RUN_PHASE(6) RUN_PHASE(7) RUN_PHASE(8) RUN_PHASE(10)
#undef RUN_PHASE
}


extern "C" void kernel_launch(void* const* d_in, const int* in_sizes, int n_in, void* d_out, int out_size, void* d_ws, size_t ws_size, hipStream_t stream) {
    static int grid = 0;
    if (grid == 0) {
        if (n_in != 18 || out_size != NT * DM || ws_size < WS_END) { fprintf(stderr, "kernel_launch: unexpected shapes (n_in %d out %d ws %zu need %zu)\n", n_in, out_size, ws_size, (size_t)WS_END); grid = -1; return; }
        int dev = 0, cus = 0;
        if (hipGetDevice(&dev) != hipSuccess || hipDeviceGetAttribute(&cus, hipDeviceAttributeMultiprocessorCount, dev) != hipSuccess) { grid = -1; return; }
        if (hipFuncSetAttribute((const void*)k_fwd, hipFuncAttributeMaxDynamicSharedMemorySize, LDS_BYTES) != hipSuccess) { fprintf(stderr, "kernel_launch: hipFuncSetAttribute failed\n"); grid = -1; return; }
        grid = cus;
    }
    if (grid < 0) return;
    (void)hipMemsetAsync((char*)d_ws + WS_BAR, 0, XCD_BAR_WORDS * 4, stream);
    KArgs a{};
    const float** pp = (const float**)&a.p;
    for (int i = 0; i < 18; ++i) pp[i] = (const float*)d_in[i];
    a.p.out = (float*)d_out; a.p.ws = (unsigned char*)d_ws;
#if N_LAUNCH_MODE == 1
    a.ph_lo = 0; a.ph_hi = N_PHASES;
    hipLaunchKernelGGL(k_fwd, dim3(grid), dim3(NTHR), LDS_BYTES, stream, a);
#else
    for (int ph = 0; ph < N_PHASES; ++ph) { a.ph_lo = ph; a.ph_hi = ph + 1; hipLaunchKernelGGL(k_fwd, dim3(grid), dim3(NTHR), LDS_BYTES, stream, a); }
#endif
}
```
